# Optimizing an MI355X kernel written in HIP

```python
import math
import jax, jax.numpy as jnp
from jax import lax
import numpy as np

D_MODEL = 2048
BATCH = 1
SEQ = 16384
DEPTH = 1

CHUNK = 64
MEM_TOKENS = 256
NORM_EPS = 1e-6

GDN_HEAD_DIM = 128
GDN_WIDTH = D_MODEL // 2
GDN_HEADS = GDN_WIDTH // GDN_HEAD_DIM
GDN_CONV = 4
GDN_COLS = 4 * GDN_WIDTH + 2 * GDN_HEADS

RWKV_HEAD_DIM = 64
RWKV_WIDTH = D_MODEL - GDN_WIDTH
RWKV_HEADS = RWKV_WIDTH // RWKV_HEAD_DIM
RWKV_DECAY_RANK = 64
RWKV_AAA_RANK = 64
RWKV_GATE_RANK = 160
RWKV_GN_EPS = 64e-5
RWKV_COLS = 3 * RWKV_WIDTH + RWKV_DECAY_RANK + RWKV_AAA_RANK + RWKV_GATE_RANK

IN_PROJ_COLS = GDN_COLS + RWKV_COLS

XA_HEADS = 4
XA_HEAD_DIM = D_MODEL // XA_HEADS

D_FF = 4 * D_MODEL

kernel_name = "hybrid_gdn_rwkv7_xattn_block"


def _rmsnorm(x, gain, eps=NORM_EPS):
    xf = x.astype(jnp.float32)
    y = xf * lax.rsqrt(jnp.mean(xf * xf, axis=-1, keepdims=True) + eps)
    return (y * gain.astype(jnp.float32)).astype(x.dtype)


def _l2norm(x, eps=1e-6):
    return x * lax.rsqrt(jnp.sum(x * x, axis=-1, keepdims=True) + eps)


def _causal_depthwise_conv(x, w):
    K, C = w.shape
    return lax.conv_general_dilated(
        x, w[:, None, :].astype(x.dtype), window_strides=(1,),
        padding=((K - 1, 0),), dimension_numbers=("NWC", "WIO", "NWC"),
        feature_group_count=C)


def _token_shift(y):
    return jnp.pad(y, ((0, 0), (1, 0), (0, 0)))[:, :-1]


def _gated_delta_chunked(q, k, v, g, beta):
    B, T, H, Dk = q.shape
    Dv = v.shape[-1]
    NC = T // CHUNK

    def chunks4(t):
        return t.reshape(B, NC, CHUNK, H, t.shape[-1]).transpose(0, 3, 1, 2, 4)

    def chunks3(t):
        return t.reshape(B, NC, CHUNK, H).transpose(0, 3, 1, 2)

    qc, kc, vc = chunks4(q), chunks4(k), chunks4(v)
    bc = chunks3(beta)
    G = jnp.cumsum(chunks3(g), axis=-1)
    idx = jnp.arange(CHUNK)
    causal = idx[:, None] >= idx[None, :]
    strict = idx[:, None] > idx[None, :]
    diff = G[..., :, None] - G[..., None, :]
    gamma = jnp.where(causal, jnp.exp(jnp.where(causal, diff, 0.0)), 0.0)

    kb = kc * bc[..., None]
    vb = vc * bc[..., None]
    M = jnp.where(strict, jnp.einsum("bhnid,bhnjd->bhnij", kb, kc) * gamma, 0.0)
    eye = jnp.eye(CHUNK, dtype=q.dtype)
    rhs = jnp.concatenate([vb, kb * jnp.exp(G)[..., None]], axis=-1)
    sol = lax.linalg.triangular_solve(M + eye, rhs, left_side=True, lower=True,
                                      unit_diagonal=True)
    U, W = sol[..., :Dv], sol[..., Dv:]
    Aqk = jnp.einsum("bhnid,bhnjd->bhnij", qc, kc) * gamma
    q_dec = qc * jnp.exp(G)[..., None]
    G_last = G[..., -1]
    k_tail = kc * jnp.exp(G_last[..., None] - G)[..., None]

    def step(S, xs):
        U_c, W_c, qd, kt, A_c, gl = xs
        v_new = U_c - jnp.einsum("bhik,bhkv->bhiv", W_c, S)
        o = jnp.einsum("bhik,bhkv->bhiv", qd, S) + jnp.einsum("bhij,bhjv->bhiv", A_c, v_new)
        S = S * jnp.exp(gl)[..., None, None] + jnp.einsum("bhik,bhiv->bhkv", kt, v_new)
        return S, o

    xs = tuple(jnp.moveaxis(t, 2, 0) for t in (U, W, q_dec, k_tail, Aqk, G_last))
    S0 = jnp.zeros((B, H, Dk, Dv), q.dtype)
    _, o = lax.scan(step, S0, xs)
    return o.transpose(1, 0, 3, 2, 4).reshape(B, T, H, Dv)


def _gdn_group(y_g, conv_w, A_log, dt_bias, norm_w):
    B, T, _ = y_g.shape
    H, Dh, GW = GDN_HEADS, GDN_HEAD_DIM, GDN_WIDTH
    qkv = jax.nn.silu(_causal_depthwise_conv(y_g[..., :3 * GW], conv_w)).astype(jnp.float32)
    q, k, v = [t.reshape(B, T, H, Dh) for t in jnp.split(qkv, 3, axis=-1)]
    q = _l2norm(q) * (Dh ** -0.5)
    k = _l2norm(k)
    yf = y_g.astype(jnp.float32)
    z = yf[..., 3 * GW:4 * GW].reshape(B, T, H, Dh)
    a_dt = yf[..., 4 * GW:4 * GW + H]
    b = yf[..., 4 * GW + H:4 * GW + 2 * H]
    g = -jnp.exp(A_log.astype(jnp.float32)) * jax.nn.softplus(a_dt + dt_bias.astype(jnp.float32))
    beta = jax.nn.sigmoid(b)
    o = _gated_delta_chunked(q, k, v, g, beta)
    o = o * lax.rsqrt(jnp.mean(o * o, axis=-1, keepdims=True) + NORM_EPS)
    o = o * norm_w.astype(jnp.float32) * jax.nn.silu(z)
    return o.reshape(B, T, GW)


def _rwkv7_scan(r, w, k, v, a_vec, b_vec):
    B, T, H, N = r.shape

    def step(S, xs):
        r_t, w_t, k_t, v_t, a_t, b_t = xs
        Sa = jnp.einsum("bhvk,bhk->bhv", S, a_t)
        S = S * w_t[:, :, None, :] + Sa[..., :, None] * b_t[..., None, :] \
            + v_t[..., :, None] * k_t[..., None, :]
        return S, jnp.einsum("bhvk,bhk->bhv", S, r_t)

    xs = tuple(jnp.moveaxis(t, 1, 0) for t in (r, w, k, v, a_vec, b_vec))
    S0 = jnp.zeros((B, H, N, N), r.dtype)
    _, o = lax.scan(step, S0, xs)
    return jnp.moveaxis(o, 0, 1)


def _rwkv_group(y_r, mu, w0, w2, a0, a2, g2, k_k, k_a, r_k, ln_w, ln_b):
    B, T, _ = y_r.shape
    H, N, W = RWKV_HEADS, RWKV_HEAD_DIM, RWKV_WIDTH
    y = y_r.astype(jnp.float32)
    y = y + (_token_shift(y) - y) * mu.astype(jnp.float32)
    r, k, v = y[..., :W], y[..., W:2 * W], y[..., 2 * W:3 * W]
    o0 = 3 * W
    w_lo = y[..., o0:o0 + RWKV_DECAY_RANK]
    a_lo = y[..., o0 + RWKV_DECAY_RANK:o0 + RWKV_DECAY_RANK + RWKV_AAA_RANK]
    g_lo = y[..., o0 + RWKV_DECAY_RANK + RWKV_AAA_RANK:]
    w_log = -jax.nn.softplus(-(w0 + jnp.tanh(w_lo) @ w2)) - 0.5
    decay = jnp.exp(-jnp.exp(w_log))
    a = jax.nn.sigmoid(a0 + a_lo @ a2)
    g = jax.nn.sigmoid(g_lo) @ g2

    def heads(t):
        return t.reshape(B, T, H, N)

    kk = _l2norm(heads(k * k_k))
    k = k * (1.0 + (a - 1.0) * k_a)
    r_h, k_h, v_h, a_h = heads(r), heads(k), heads(v), heads(a)
    o = _rwkv7_scan(r_h, heads(decay), k_h, v_h, -kk, kk * a_h)
    mean = jnp.mean(o, axis=-1, keepdims=True)
    var = jnp.mean(jnp.square(o - mean), axis=-1, keepdims=True)
    o = ((o - mean) * lax.rsqrt(var + RWKV_GN_EPS)).reshape(B, T, W) * ln_w + ln_b
    bonus = jnp.sum(r_h * k_h * r_k, axis=-1, keepdims=True) * v_h
    return (o + bonus.reshape(B, T, W)) * g


def _cross_attention(hn, mn, wq, wk, wv, wo):
    B, T, D = hn.shape
    M = mn.shape[1]
    q = (hn @ wq).reshape(B, T, XA_HEADS, XA_HEAD_DIM)
    k = (mn @ wk).reshape(B, M, XA_HEADS, XA_HEAD_DIM)
    v = (mn @ wv).reshape(B, M, XA_HEADS, XA_HEAD_DIM)
    s = jnp.einsum("bthd,bmhd->bhtm", q, k).astype(jnp.float32) * (XA_HEAD_DIM ** -0.5)
    p = jax.nn.softmax(s, axis=-1).astype(hn.dtype)
    o = jnp.einsum("bhtm,bmhd->bthd", p, v).reshape(B, T, D)
    return o @ wo


def setup_inputs(seed: int = 0) -> dict:
    key = jax.random.key(seed)
    keys = jax.random.split(key, 32)
    counter = [0]

    def nk():
        counter[0] += 1
        return keys[counter[0] - 1]

    f32 = jnp.float32
    L, D = DEPTH, D_MODEL

    def nrm(shape, scale):
        return jax.random.normal(nk(), shape, f32) * scale

    def gain(shape):
        return 1.0 + nrm(shape, 0.02)

    x = nrm((BATCH, SEQ, D), 1.0)
    mem = nrm((BATCH, MEM_TOKENS, D), 1.0)
    norm_mix = gain((L, D))
    w_in = nrm((L, D, IN_PROJ_COLS), D ** -0.5)
    gdn_conv_w = nrm((L, GDN_CONV, 3 * GDN_WIDTH), GDN_CONV ** -0.5)
    gdn_A_log = jnp.log(jax.random.uniform(nk(), (L, GDN_HEADS), f32, 1.0, 16.0))
    dt = jnp.exp(jax.random.uniform(nk(), (L, GDN_HEADS), f32, math.log(1e-3), math.log(1e-1)))
    gdn_dt_bias = dt + jnp.log(-jnp.expm1(-dt))
    gdn_norm_w = gain((L, GDN_HEAD_DIM))
    rwkv_mu = jax.random.uniform(nk(), (L, RWKV_COLS), f32, 0.0, 1.0)
    rwkv_w0 = jax.random.uniform(nk(), (L, RWKV_WIDTH), f32, -6.0, -0.5)
    rwkv_w2 = nrm((L, RWKV_DECAY_RANK, RWKV_WIDTH), 0.2 * RWKV_DECAY_RANK ** -0.5)
    rwkv_a0 = nrm((L, RWKV_WIDTH), 0.1)
    rwkv_a2 = nrm((L, RWKV_AAA_RANK, RWKV_WIDTH), 0.5 * RWKV_AAA_RANK ** -0.5)
    rwkv_g2 = nrm((L, RWKV_GATE_RANK, RWKV_WIDTH), RWKV_GATE_RANK ** -0.5)
    rwkv_k_k = 0.85 + nrm((L, RWKV_WIDTH), 0.02)
    rwkv_k_a = gain((L, RWKV_WIDTH))
    rwkv_r_k = nrm((L, RWKV_HEADS, RWKV_HEAD_DIM), 0.1)
    rwkv_ln_w = gain((L, RWKV_WIDTH))
    rwkv_ln_b = nrm((L, RWKV_WIDTH), 0.01)
    w_out = nrm((L, D, D), D ** -0.5)
    norm_xattn = gain((L, D))
    norm_mem = gain((L, D))
    xattn_wq = nrm((L, D, D), D ** -0.5)
    xattn_wk = nrm((L, D, D), D ** -0.5)
    xattn_wv = nrm((L, D, D), D ** -0.5)
    xattn_wo = nrm((L, D, D), D ** -0.5)
    norm_mlp = gain((L, D))
    mlp_w_up = nrm((L, D, D_FF), D ** -0.5)
    mlp_w_down = nrm((L, D_FF, D), D_FF ** -0.5)
    norm_final = gain((D,))
    return {"x": x, "mem": mem, "norm_mix": norm_mix, "w_in": w_in,
            "gdn_conv_w": gdn_conv_w, "gdn_A_log": gdn_A_log, "gdn_dt_bias": gdn_dt_bias,
            "gdn_norm_w": gdn_norm_w, "rwkv_mu": rwkv_mu, "rwkv_w0": rwkv_w0,
            "rwkv_w2": rwkv_w2, "rwkv_a0": rwkv_a0, "rwkv_a2": rwkv_a2, "rwkv_g2": rwkv_g2,
            "rwkv_k_k": rwkv_k_k, "rwkv_k_a": rwkv_k_a, "rwkv_r_k": rwkv_r_k,
            "rwkv_ln_w": rwkv_ln_w, "rwkv_ln_b": rwkv_ln_b, "w_out": w_out,
            "norm_xattn": norm_xattn, "norm_mem": norm_mem, "xattn_wq": xattn_wq,
            "xattn_wk": xattn_wk, "xattn_wv": xattn_wv, "xattn_wo": xattn_wo,
            "norm_mlp": norm_mlp, "mlp_w_up": mlp_w_up, "mlp_w_down": mlp_w_down,
            "norm_final": norm_final}


def reference(x, mem, norm_mix, w_in, gdn_conv_w, gdn_A_log, gdn_dt_bias, gdn_norm_w,
              rwkv_mu, rwkv_w0, rwkv_w2, rwkv_a0, rwkv_a2, rwkv_g2, rwkv_k_k, rwkv_k_a,
              rwkv_r_k, rwkv_ln_w, rwkv_ln_b, w_out, norm_xattn, norm_mem, xattn_wq,
              xattn_wk, xattn_wv, xattn_wo, norm_mlp, mlp_w_up, mlp_w_down, norm_final):
    h = x
    for l in range(DEPTH):
        xn = _rmsnorm(h, norm_mix[l])
        y = xn @ w_in[l]
        o_gdn = _gdn_group(y[..., :GDN_COLS], gdn_conv_w[l], gdn_A_log[l],
                           gdn_dt_bias[l], gdn_norm_w[l])
        o_rwkv = _rwkv_group(y[..., GDN_COLS:], rwkv_mu[l], rwkv_w0[l], rwkv_w2[l],
                             rwkv_a0[l], rwkv_a2[l], rwkv_g2[l], rwkv_k_k[l], rwkv_k_a[l],
                             rwkv_r_k[l], rwkv_ln_w[l], rwkv_ln_b[l])
        mixed = jnp.concatenate([o_gdn, o_rwkv], axis=-1).astype(h.dtype)
        h = h + mixed @ w_out[l]
        h = h + _cross_attention(_rmsnorm(h, norm_xattn[l]), _rmsnorm(mem, norm_mem[l]),
                                 xattn_wq[l], xattn_wk[l], xattn_wv[l], xattn_wo[l])
        hn = _rmsnorm(h, norm_mlp[l])
        h = h + jnp.square(jax.nn.relu(hn @ mlp_w_up[l])) @ mlp_w_down[l]
    return _rmsnorm(h, norm_final)
```

```cpp
#include <hip/hip_runtime.h>
#include <hip/hip_cooperative_groups.h>
#include <cstdio>
namespace cg = cooperative_groups;

#define LAS __attribute__((address_space(3)))
typedef unsigned short bf16_t;
typedef short bf16x8 __attribute__((ext_vector_type(8)));
typedef float f32x4 __attribute__((ext_vector_type(4)));

constexpr int T = 16384, D = 2048, NIN = 7472, NINP = 7680, DFF = 8192;
constexpr int GDN_COLS = 4112, RW0 = 4112;
constexpr int SEG = 2048, NSEG = 8;
constexpr int RREC = 384, GREC = 388;

constexpr size_t al(size_t x) { return (x + 255) & ~(size_t)255; }
constexpr size_t OFF_WIN = 0;
constexpr size_t OFF_WOUT = OFF_WIN + (size_t)NINP * D * 2;
constexpr size_t OFF_WQ = OFF_WOUT + (size_t)D * D * 2;
constexpr size_t OFF_WK = OFF_WQ + (size_t)D * D * 2;
constexpr size_t OFF_WV = OFF_WK + (size_t)D * D * 2;
constexpr size_t OFF_WO = OFF_WV + (size_t)D * D * 2;
constexpr size_t OFF_WUP = OFF_WO + (size_t)D * D * 2;
constexpr size_t OFF_WDN = OFF_WUP + (size_t)DFF * D * 2;
constexpr size_t OFF_MN = OFF_WDN + (size_t)DFF * D * 2;
constexpr size_t OFF_KX = OFF_MN + (size_t)256 * D * 2;
constexpr size_t OFF_VT = OFF_KX + (size_t)256 * D * 2;
constexpr size_t OFF_RSTDX = OFF_VT + (size_t)256 * D * 2;
constexpr size_t OFF_SSQ1 = OFF_RSTDX + (size_t)T * 4;
constexpr size_t OFF_SSQ2 = OFF_SSQ1 + (size_t)T * 32 * 4;
constexpr size_t OFF_PROW = OFF_SSQ2 + (size_t)T * 32 * 4;
constexpr size_t OFF_CARRY = OFF_PROW + (size_t)T * 16 * 4;
constexpr size_t OFF_SG = OFF_CARRY + al((size_t)2 * 3 * NINP * 4);
constexpr size_t OFF_SR = OFF_SG + (size_t)8 * 128 * 128 * 4;
constexpr size_t OFF_AB0 = OFF_SR + (size_t)16 * 64 * 64 * 4;
constexpr size_t OFF_AB1 = OFF_AB0 + (size_t)T * D * 2;
constexpr size_t OFF_BIG = OFF_AB1 + (size_t)T * D * 2;
constexpr size_t OFF_YSEG = OFF_BIG;
constexpr size_t OFF_RREC = OFF_YSEG + (size_t)SEG * NINP * 4;
constexpr size_t OFF_GREC = OFF_RREC + (size_t)SEG * 16 * RREC * 4;
constexpr size_t OFF_BONUS = OFF_GREC + (size_t)SEG * 8 * GREC * 4;
constexpr size_t OFF_GATE = OFF_BONUS + (size_t)SEG * 1024 * 4;
constexpr size_t OFF_SZ = OFF_GATE + (size_t)SEG * 1024 * 4;
constexpr size_t OFF_ORW = OFF_SZ + (size_t)SEG * 1024 * 4;
constexpr size_t OFF_OGD = OFF_ORW + (size_t)SEG * 1024 * 4;
constexpr size_t OFF_END1 = OFF_OGD + (size_t)SEG * 1024 * 4;
constexpr size_t OFF_U = OFF_AB1;
constexpr size_t OFF_END2 = OFF_U + (size_t)T * DFF * 2;
static_assert(OFF_END1 <= 536870912ull, "ws overflow 1");
static_assert(OFF_END2 <= 536870912ull, "ws overflow 2");

constexpr int LDS_BYTES = 139264;

struct Params {
    const float* in[30];
    float* out;
    unsigned char* ws;
};

__device__ __forceinline__ bf16_t f2bf(float f) { unsigned u = __float_as_uint(f); u += 0x7FFFu + ((u >> 16) & 1u); return (bf16_t)(u >> 16); }
__device__ __forceinline__ unsigned pack2(float a, float b) { return (unsigned)f2bf(a) | ((unsigned)f2bf(b) << 16); }
__device__ __forceinline__ float wsum(float v) {
#pragma unroll
    for (int o = 32; o > 0; o >>= 1) v += __shfl_xor(v, o);
    return v;
}
__device__ __forceinline__ float sigmoidf_(float x) { return 1.f / (1.f + __expf(-x)); }
__device__ __forceinline__ float softplusf_(float x) { return x > 20.f ? x : log1pf(__expf(x)); }
__device__ __forceinline__ float siluf_(float x) { return x / (1.f + __expf(-x)); }
template <int CTRL> __device__ __forceinline__ float dppf(float x) { return __int_as_float(__builtin_amdgcn_update_dpp(0, __float_as_int(x), CTRL, 0xF, 0xF, false)); }
__device__ __forceinline__ float allred16(float x) {
    x += dppf<0xB1>(x);
    x += dppf<0x4E>(x);
    x += dppf<0x124>(x);
    x += dppf<0x128>(x);
    return x;
}

__device__ __forceinline__ int ltid() { int t = threadIdx.x; asm volatile("" : "+v"(t)); return t; }

namespace pg8 {
constexpr int BM = 256, BK = 64, HALF = 128, HTB = HALF * BK * 2, NXCD = 8, WGM = 8;
__device__ __forceinline__ int lds_byte(int r, int c) { const int st = (r >> 4) * 2 + (c >> 5), rr = r & 15, cc = c & 31, ob = rr * 64 + cc * 2; return st * 1024 + (ob ^ (((ob >> 9) & 1) << 5)); }
__device__ __forceinline__ void stage_rc(int b, int& R, int& C) { const int st = b / 1024, sb = b % 1024, swz = sb ^ (((sb >> 9) & 1) << 5); R = (st >> 1) * 16 + swz / 64; C = (st & 1) * 32 + (swz % 64) / 2; }

struct Unit { int pm, pn, b; };
struct Gemm { const bf16_t* A; const bf16_t* Bt; int lda, ldb, K, nM, nN, nB; size_t sA, sB; };

struct Order {
    int nM, nN, per, nwg, G, c;
    __device__ void init(const Gemm& g, int G_, int c_) { nM = g.nM; nN = g.nN; per = nM * nN; nwg = per * g.nB; G = G_; c = c_; }
    __device__ bool next(int i, Unit& u) const {
        const long L = (long)i * G + c; if (L >= nwg) return false;
        u.b = (int)(L / per); int wgid = (int)(L % per);
        { const int q = per / NXCD, r = per % NXCD, xcd = wgid % NXCD, off = wgid / NXCD; wgid = (xcd < r ? xcd * (q + 1) : r * (q + 1) + (xcd - r) * q) + off; }
        const int nig = WGM * nN, gid = wgid / nig, fm = gid * WGM, gsz = (nM - fm) < WGM ? (nM - fm) : WGM;
        u.pm = fm + ((wgid % nig) % gsz); u.pn = (wgid % nig) / gsz; return true;
    }
};

template <class Epi>
__device__ __forceinline__ void gemm_phase(LAS unsigned char* lds, const Gemm g, const Order& S, const Epi& E) {
    int tid_ = threadIdx.x; asm volatile("" : "+v"(tid_));
    const int tid = tid_, wid = __builtin_amdgcn_readfirstlane(tid >> 6), lane = tid & 63, wr = wid >> 2, wc = wid & 3, fr = lane & 15, fq = lane >> 4;
    const int K = g.K, nt = K / BK;
    unsigned voffA[2], voffB[2];
#pragma unroll
    for (int i = 0; i < 2; ++i) { int R, C; stage_rc(tid * 16 + i * 8192, R, C);
        voffA[i] = (unsigned)(R * g.lda + C) * 2u; voffB[i] = (unsigned)(R * g.ldb + C) * 2u; }
    const size_t kstep = (size_t)(BK * 2);
    const size_t hstepA = (size_t)HALF * g.lda * 2, hstepB = (size_t)HALF * g.ldb * 2;
    const size_t tstepA = 2 * hstepA, tstepB = 2 * hstepB;
    const unsigned ldsw = (unsigned)wid * 1024u;
    const int aoff = lds_byte(wr * 64 + fr, fq * 8), boff = lds_byte(wc * 32 + fr, fq * 8);
#define PG8_SA(b, h) (((b) * 2 + (h)) * HTB)
#define PG8_SB(b, h) ((4 + (b) * 2 + (h)) * HTB)
#define PG8_STAGE(bufoff, gbase, voff) do { _Pragma("unroll") for (int _i = 0; _i < 2; ++_i) \
        __builtin_amdgcn_global_load_lds((const unsigned*)((const char*)(gbase) + (voff)[_i]), (LAS unsigned*)(lds + (bufoff) + ldsw + _i * 8192), 16, 0, 0); } while (0)
#define PG8_LDA(dst, b, h) do { _Pragma("unroll") for (int m = 0; m < 4; ++m) _Pragma("unroll") for (int k = 0; k < 2; ++k) dst[m][k] = *(const LAS bf16x8*)(lds + PG8_SA(b, h) + aoff + m * 2048 + k * 1024); } while (0)
#define PG8_LDB(dst, b, h) do { _Pragma("unroll") for (int n = 0; n < 2; ++n) _Pragma("unroll") for (int k = 0; k < 2; ++k) dst[n][k] = *(const LAS bf16x8*)(lds + PG8_SB(b, h) + boff + n * 2048 + k * 1024); } while (0)
#define PG8_MMA(ai, bj, At, Bt) do { __builtin_amdgcn_s_setprio(1); _Pragma("unroll") for (int m = 0; m < 4; ++m) _Pragma("unroll") for (int n = 0; n < 2; ++n) _Pragma("unroll") for (int k = 0; k < 2; ++k) \
        acc[ai][bj][m][n] = __builtin_amdgcn_mfma_f32_16x16x32_bf16(Bt[n][k], At[m][k], acc[ai][bj][m][n], 0, 0, 0); __builtin_amdgcn_s_setprio(0); } while (0)
#define PG8_WAIT_V(n) asm volatile("s_waitcnt vmcnt(" #n ")" ::: "memory")
#define PG8_WAIT_L(n) asm volatile("s_waitcnt lgkmcnt(" #n ")" ::: "memory")
#define PG8_BAR __builtin_amdgcn_s_barrier()
#define PG8_SCHED __builtin_amdgcn_sched_barrier(0)
    Unit cur, nxt; int ui = 0;
    if (!S.next(0, cur)) return;
    f32x4 acc[2][2][4][2];
#pragma unroll
    for (int a = 0; a < 2; ++a)
#pragma unroll
        for (int b = 0; b < 2; ++b)
#pragma unroll
            for (int m = 0; m < 4; ++m)
#pragma unroll
                for (int n = 0; n < 2; ++n) acc[a][b][m][n] = (f32x4){0.f, 0.f, 0.f, 0.f};
    bf16x8 At[4][2], B0[2][2], B1[2][2];
    const char* cA = (const char*)g.A + (size_t)cur.b * g.sA * 2 + (size_t)cur.pm * tstepA; const char* cB = (const char*)g.Bt + (size_t)cur.b * g.sB * 2 + (size_t)cur.pn * tstepB;
    PG8_STAGE(PG8_SB(0, 0), cB, voffB); PG8_STAGE(PG8_SA(0, 0), cA, voffA); PG8_STAGE(PG8_SB(0, 1), cB + hstepB, voffB); PG8_STAGE(PG8_SA(0, 1), cA + hstepA, voffA);
    if (wr == 1) PG8_BAR;
    PG8_WAIT_V(4); PG8_BAR;
    PG8_STAGE(PG8_SB(1, 0), cB + kstep, voffB); PG8_STAGE(PG8_SA(1, 0), cA + kstep, voffA); PG8_STAGE(PG8_SB(1, 1), cB + hstepB + kstep, voffB);
    PG8_WAIT_V(6); PG8_BAR;
    for (;;) {
        const bool has_next = S.next(ui + 1, nxt);
        const char* nA = has_next ? (const char*)g.A + (size_t)nxt.b * g.sA * 2 + (size_t)nxt.pm * tstepA : cA; const char* nB = has_next ? (const char*)g.Bt + (size_t)nxt.b * g.sB * 2 + (size_t)nxt.pn * tstepB : cB;
        for (int t = 0; t < nt; t += 2) {
            const bool last = (t == nt - 2);
            const char* a1 = cA + (size_t)(t + 1) * kstep;
            const char* a2 = last ? nA : cA + (size_t)(t + 2) * kstep; const char* b2 = last ? nB : cB + (size_t)(t + 2) * kstep;
            const char* a3 = a2 + kstep; const char* b3 = b2 + kstep;
            PG8_LDB(B0, 0, 0); PG8_SCHED; PG8_LDA(At, 0, 0); PG8_STAGE(PG8_SA(1, 1), a1 + hstepA, voffA);
            PG8_WAIT_L(8); PG8_BAR; PG8_WAIT_L(0); PG8_MMA(0, 0, At, B0); PG8_BAR; PG8_SCHED;
            PG8_LDB(B1, 0, 1); PG8_STAGE(PG8_SB(0, 0), b2, voffB);
            PG8_BAR; PG8_WAIT_L(0); PG8_MMA(0, 1, At, B1); PG8_BAR;
            PG8_LDA(At, 0, 1); PG8_STAGE(PG8_SA(0, 0), a2, voffA);
            PG8_BAR; PG8_WAIT_L(0); PG8_MMA(1, 0, At, B0); PG8_BAR; PG8_SCHED;
            PG8_STAGE(PG8_SB(0, 1), b2 + hstepB, voffB);
            PG8_WAIT_V(6); PG8_BAR; PG8_MMA(1, 1, At, B1); PG8_BAR;
            PG8_LDB(B0, 1, 0); PG8_SCHED; PG8_LDA(At, 1, 0); PG8_STAGE(PG8_SA(0, 1), a2 + hstepA, voffA);
            PG8_WAIT_L(8); PG8_BAR; PG8_WAIT_L(0); PG8_MMA(0, 0, At, B0); PG8_BAR; PG8_SCHED;
            PG8_LDB(B1, 1, 1); PG8_STAGE(PG8_SB(1, 0), b3, voffB);
            PG8_BAR; PG8_WAIT_L(0); PG8_MMA(0, 1, At, B1); PG8_BAR;
            PG8_LDA(At, 1, 1); PG8_STAGE(PG8_SA(1, 0), a3, voffA);
            PG8_BAR; PG8_WAIT_L(0); PG8_MMA(1, 0, At, B0); PG8_BAR; PG8_SCHED;
            PG8_STAGE(PG8_SB(1, 1), b3 + hstepB, voffB);
            PG8_WAIT_V(6); PG8_BAR; PG8_MMA(1, 1, At, B1); PG8_BAR;
        }
        E(acc, cur, wr, wc, fr, fq);
        if (!has_next) break;
#pragma unroll
        for (int a = 0; a < 2; ++a)
#pragma unroll
            for (int b = 0; b < 2; ++b)
#pragma unroll
                for (int m = 0; m < 4; ++m)
#pragma unroll
                    for (int n = 0; n < 2; ++n) acc[a][b][m][n] = (f32x4){0.f, 0.f, 0.f, 0.f};
        cur = nxt; cA = nA; cB = nB; ++ui;
    }
    PG8_WAIT_V(0);
    if (wr == 0) PG8_BAR;
    PG8_BAR;
#undef PG8_SA
#undef PG8_SB
#undef PG8_STAGE
#undef PG8_LDA
#undef PG8_LDB
#undef PG8_MMA
#undef PG8_WAIT_V
#undef PG8_WAIT_L
#undef PG8_BAR
#undef PG8_SCHED
}
}
using pg8::Unit;
using pg8::Gemm;

__device__ __forceinline__ float rs_from(const float* ssq, int row) {
    const float4* p = (const float4*)(ssq + (size_t)row * 32); float s = 0.f;
#pragma unroll
    for (int i = 0; i < 8; ++i) { float4 v = p[i]; s += (v.x + v.y) + (v.z + v.w); }
    return rsqrtf(s * (1.f / 2048.f) + 1e-6f);
}
struct EpiY {
    float* Y; int ldc; const float* rstd;
    __device__ __forceinline__ void operator()(const f32x4 (&acc)[2][2][4][2], const Unit& u, int wr, int wc, int fr, int fq) const {
        const int row0 = u.pm * 256 + wr * 64 + fr, col0 = u.pn * 256 + wc * 32 + 4 * fq;
#pragma unroll
        for (int ai = 0; ai < 2; ++ai)
#pragma unroll
            for (int m = 0; m < 4; ++m) { __builtin_amdgcn_sched_barrier(0); const int row = row0 + ai * 128 + m * 16; const float rs = rstd ? rstd[row] : 1.f; float* rowp = Y + (size_t)row * ldc + col0;
#pragma unroll
                for (int bj = 0; bj < 2; ++bj)
#pragma unroll
                    for (int n = 0; n < 2; ++n) *(f32x4*)(rowp + bj * 128 + n * 16) = acc[ai][bj][m][n] * rs; }
    }
};
struct EpiBf {
    bf16_t* O; int ldc; const float* ssq;
    __device__ __forceinline__ void operator()(const f32x4 (&acc)[2][2][4][2], const Unit& u, int wr, int wc, int fr, int fq) const {
        const int row0 = u.pm * 256 + wr * 64 + fr, col0 = u.pn * 256 + wc * 32 + 4 * fq;
#pragma unroll
        for (int ai = 0; ai < 2; ++ai)
#pragma unroll
            for (int m = 0; m < 4; ++m) { __builtin_amdgcn_sched_barrier(0); const int row = row0 + ai * 128 + m * 16; const float rs = ssq ? rs_from(ssq, row) : 1.f; bf16_t* rowp = O + (size_t)row * ldc + col0;
#pragma unroll
                for (int bj = 0; bj < 2; ++bj)
#pragma unroll
                    for (int n = 0; n < 2; ++n) { f32x4 v = acc[ai][bj][m][n] * rs; uint2 o; o.x = pack2(v[0], v[1]); o.y = pack2(v[2], v[3]); *(uint2*)(rowp + bj * 128 + n * 16) = o; } }
    }
};
struct EpiUp {
    bf16_t* O; int ldc; const float* ssq;
    __device__ __forceinline__ void operator()(const f32x4 (&acc)[2][2][4][2], const Unit& u, int wr, int wc, int fr, int fq) const {
        const int row0 = u.pm * 256 + wr * 64 + fr, col0 = u.pn * 256 + wc * 32 + 4 * fq;
#pragma unroll
        for (int ai = 0; ai < 2; ++ai)
#pragma unroll
            for (int m = 0; m < 4; ++m) { __builtin_amdgcn_sched_barrier(0); const int row = row0 + ai * 128 + m * 16; const float rs = rs_from(ssq, row); bf16_t* rowp = O + (size_t)row * ldc + col0;
#pragma unroll
                for (int bj = 0; bj < 2; ++bj)
#pragma unroll
                    for (int n = 0; n < 2; ++n) { f32x4 v = acc[ai][bj][m][n] * rs;
                        float a = fmaxf(v[0], 0.f), b = fmaxf(v[1], 0.f), c = fmaxf(v[2], 0.f), d = fmaxf(v[3], 0.f);
                        uint2 o; o.x = pack2(a * a, b * b); o.y = pack2(c * c, d * d); *(uint2*)(rowp + bj * 128 + n * 16) = o; } }
    }
};
struct EpiRes {
    const float* R; float* H; bf16_t* HB; float* ssq;
    __device__ __forceinline__ void operator()(const f32x4 (&acc)[2][2][4][2], const Unit& u, int wr, int wc, int fr, int fq) const {
        const int row0 = u.pm * 256 + wr * 64 + fr, col0 = u.pn * 256 + wc * 32 + 4 * fq;
#pragma unroll
        for (int ai = 0; ai < 2; ++ai)
#pragma unroll
            for (int m = 0; m < 4; ++m) { __builtin_amdgcn_sched_barrier(0); const int row = row0 + ai * 128 + m * 16; const size_t ro = (size_t)row * 2048 + col0; float s = 0.f;
#pragma unroll
                for (int bj = 0; bj < 2; ++bj)
#pragma unroll
                    for (int n = 0; n < 2; ++n) { const size_t o = ro + bj * 128 + n * 16; f32x4 v = acc[ai][bj][m][n] + *(const f32x4*)(R + o); *(f32x4*)(H + o) = v;
                        s += v[0] * v[0] + v[1] * v[1] + v[2] * v[2] + v[3] * v[3];
                        if (HB) { uint2 pk; pk.x = pack2(v[0], v[1]); pk.y = pack2(v[2], v[3]); *(uint2*)(HB + o) = pk; } }
                if (ssq) { s += __shfl_xor(s, 16); s += __shfl_xor(s, 32); if (fq == 0) ssq[(size_t)row * 32 + u.pn * 4 + wc] = s; } }
    }
};
struct EpiScore {
    bf16_t* P; float* prow; float scale;
    __device__ __forceinline__ void operator()(const f32x4 (&acc)[2][2][4][2], const Unit& u, int wr, int wc, int fr, int fq) const {
        const int row0 = u.pm * 256 + wr * 64 + fr, col0 = u.b * 256 + wc * 32 + 4 * fq;
#pragma unroll
        for (int ai = 0; ai < 2; ++ai)
#pragma unroll
            for (int m = 0; m < 4; ++m) { __builtin_amdgcn_sched_barrier(0); const int row = row0 + ai * 128 + m * 16; bf16_t* rowp = P + (size_t)row * 1024 + col0; float s = 0.f;
#pragma unroll
                for (int bj = 0; bj < 2; ++bj)
#pragma unroll
                    for (int n = 0; n < 2; ++n) { f32x4 v = acc[ai][bj][m][n] * scale;
                        float a = __expf(fminf(v[0], 80.f)), b = __expf(fminf(v[1], 80.f)), c = __expf(fminf(v[2], 80.f)), d = __expf(fminf(v[3], 80.f));
                        s += (a + b) + (c + d); uint2 o; o.x = pack2(a, b); o.y = pack2(c, d); *(uint2*)(rowp + bj * 128 + n * 16) = o; }
                s += __shfl_xor(s, 16); s += __shfl_xor(s, 32); if (fq == 0) prow[(size_t)row * 16 + u.b * 4 + wc] = s; }
    }
};
struct EpiPV {
    bf16_t* O; const float* prow;
    __device__ __forceinline__ void operator()(const f32x4 (&acc)[2][2][4][2], const Unit& u, int wr, int wc, int fr, int fq) const {
        const int row0 = u.pm * 256 + wr * 64 + fr, col0 = u.b * 512 + u.pn * 256 + wc * 32 + 4 * fq;
#pragma unroll
        for (int ai = 0; ai < 2; ++ai)
#pragma unroll
            for (int m = 0; m < 4; ++m) { __builtin_amdgcn_sched_barrier(0); const int row = row0 + ai * 128 + m * 16; const float4 pr = *(const float4*)(prow + (size_t)row * 16 + u.b * 4);
                const float inv = 1.f / ((pr.x + pr.y) + (pr.z + pr.w)); bf16_t* rowp = O + (size_t)row * 2048 + col0;
#pragma unroll
                for (int bj = 0; bj < 2; ++bj)
#pragma unroll
                    for (int n = 0; n < 2; ++n) { f32x4 v = acc[ai][bj][m][n] * inv; uint2 o; o.x = pack2(v[0], v[1]); o.y = pack2(v[2], v[3]); *(uint2*)(rowp + bj * 128 + n * 16) = o; } }
    }
};

template <class Epi>
__device__ __forceinline__ void run_gemm(LAS unsigned char* lds, const bf16_t* A, const bf16_t* Bt, int lda, int ldb, int K, int nM, int nN, int nB, size_t sA, size_t sB, const Epi& E, int cshift) {
    Gemm g; g.A = A; g.Bt = Bt; g.lda = lda; g.ldb = ldb; g.K = K; g.nM = nM; g.nN = nN; g.nB = nB; g.sA = sA; g.sB = sB;
    pg8::Order S; S.init(g, (int)gridDim.x, (int)((blockIdx.x + cshift) % gridDim.x));
    pg8::gemm_phase<Epi>(lds, g, S, E);
}

__device__ void convT(const float* __restrict__ src, bf16_t* __restrict__ dst, const float* __restrict__ gain, int K, int N, int Npad, float* tile) {
    const int tidx = ltid();
    const int tn = Npad / 64, ntile = (K / 64) * tn;
    for (int t = blockIdx.x; t < ntile; t += gridDim.x) {
        const int k0 = (t / tn) * 64, n0 = (t % tn) * 64;
        const int nn = tidx & 63, kb = tidx >> 6;
#pragma unroll
        for (int i = 0; i < 8; ++i) { const int kk = kb + 8 * i, n = n0 + nn; float v = (n < N) ? src[(size_t)(k0 + kk) * N + n] : 0.f; if (gain) v *= gain[k0 + kk]; tile[kk * 65 + nn] = v; }
        __syncthreads();
        const int kp = (tidx & 31) * 2, nb2 = tidx >> 5;
#pragma unroll
        for (int i = 0; i < 4; ++i) { const int n2 = nb2 + 16 * i; *(unsigned*)(dst + (size_t)(n0 + n2) * K + k0 + kp) = pack2(tile[kp * 65 + n2], tile[(kp + 1) * 65 + n2]); }
        __syncthreads();
    }
}
__device__ void rows_to_bf16(const float* __restrict__ x, bf16_t* __restrict__ xb, float* __restrict__ rstd, const float* __restrict__ gain, int rows) {
    const int tidx = ltid();
    const int gw = blockIdx.x * 8 + (tidx >> 6), nw = gridDim.x * 8, lane = tidx & 63;
    for (int r = gw; r < rows; r += nw) {
        const float4* p = (const float4*)(x + (size_t)r * 2048);
        float4 v[8]; float ss = 0.f;
#pragma unroll
        for (int i = 0; i < 8; ++i) { v[i] = p[i * 64 + lane]; ss += v[i].x * v[i].x + v[i].y * v[i].y + v[i].z * v[i].z + v[i].w * v[i].w; }
        ss = wsum(ss); const float rs = rsqrtf(ss * (1.f / 2048.f) + 1e-6f);
        if (rstd && lane == 0) rstd[r] = rs;
#pragma unroll
        for (int i = 0; i < 8; ++i) { float4 w = v[i];
            if (gain) { const float4 gg = ((const float4*)gain)[i * 64 + lane]; w.x *= rs * gg.x; w.y *= rs * gg.y; w.z *= rs * gg.z; w.w *= rs * gg.w; }
            uint2 o; o.x = pack2(w.x, w.y); o.y = pack2(w.z, w.w); *(uint2*)(xb + (size_t)r * 2048 + (size_t)(i * 64 + lane) * 4) = o; }
    }
}

__device__ __forceinline__ float yget(const float* yseg, const float* carry_prev, int seg, int tl, int col) {
    if (tl >= 0) return yseg[(size_t)tl * NINP + col];
    if (seg == 0) return 0.f;
    return carry_prev[(size_t)(3 + tl) * NINP + col];
}
__device__ void rwkv_prep_tile(const Params& p, int seg, int tile, float* act  ) {
    const int tidx = ltid();
    const float* yseg = (const float*)(p.ws + OFF_YSEG);
    const float* carry_prev = (const float*)(p.ws + OFF_CARRY) + (size_t)((seg + 1) & 1) * 3 * NINP;
    const float* mu = p.in[8]; const float* w0 = p.in[9]; const float* w2 = p.in[10]; const float* a0 = p.in[11]; const float* a2 = p.in[12]; const float* g2 = p.in[13];
    const float* k_k = p.in[14]; const float* k_a = p.in[15]; const float* r_k = p.in[16];
    float* rrec = (float*)(p.ws + OFF_RREC); float* bonus = (float*)(p.ws + OFF_BONUS); float* gate = (float*)(p.ws + OFF_GATE);
    const int tid = tidx, tl0 = tile * 16;
    __syncthreads();
    for (int idx = tid; idx < 16 * 288; idx += 512) {
        const int tok = idx / 288, i = idx % 288, col = RW0 + 3072 + i, tl = tl0 + tok;
        const float cur = yseg[(size_t)tl * NINP + col], prev = yget(yseg, carry_prev, seg, tl - 1, col);
        const float yl = cur + (prev - cur) * mu[3072 + i];
        act[i * 16 + tok] = i < 64 ? tanhf(yl) : (i < 128 ? yl : sigmoidf_(yl));
    }
    __syncthreads();
#pragma unroll 1
    for (int cc = 0; cc < 2; ++cc) {
        const int c = tid + cc * 512, h = c >> 6, j = c & 63;
        float aw[16], aa[16], ag[16];
#pragma unroll
        for (int q = 0; q < 16; ++q) { aw[q] = 0.f; aa[q] = 0.f; ag[q] = 0.f; }
#pragma unroll 2
        for (int i = 0; i < 64; ++i) { const float w = w2[i * 1024 + c]; const float4* ap = (const float4*)(act + i * 16);
#pragma unroll
            for (int q4 = 0; q4 < 4; ++q4) { const float4 a = ap[q4]; aw[q4 * 4 + 0] += a.x * w; aw[q4 * 4 + 1] += a.y * w; aw[q4 * 4 + 2] += a.z * w; aw[q4 * 4 + 3] += a.w * w; } }
#pragma unroll 2
        for (int i = 0; i < 64; ++i) { const float w = a2[i * 1024 + c]; const float4* ap = (const float4*)(act + (64 + i) * 16);
#pragma unroll
            for (int q4 = 0; q4 < 4; ++q4) { const float4 a = ap[q4]; aa[q4 * 4 + 0] += a.x * w; aa[q4 * 4 + 1] += a.y * w; aa[q4 * 4 + 2] += a.z * w; aa[q4 * 4 + 3] += a.w * w; } }
#pragma unroll 2
        for (int i = 0; i < 160; ++i) { const float w = g2[i * 1024 + c]; const float4* ap = (const float4*)(act + (128 + i) * 16);
#pragma unroll
            for (int q4 = 0; q4 < 4; ++q4) { const float4 a = ap[q4]; ag[q4 * 4 + 0] += a.x * w; ag[q4 * 4 + 1] += a.y * w; ag[q4 * 4 + 2] += a.z * w; ag[q4 * 4 + 3] += a.w * w; } }
        const float w0c = w0[c], a0c = a0[c], kkc = k_k[c], kac = k_a[c], rkc = r_k[c], mur = mu[c], muk = mu[1024 + c], muv = mu[2048 + c];
#pragma unroll
        for (int q = 0; q < 16; ++q) {
            const int tl = tl0 + q;
            const float rc = yseg[(size_t)tl * NINP + RW0 + c], kc = yseg[(size_t)tl * NINP + RW0 + 1024 + c], vc = yseg[(size_t)tl * NINP + RW0 + 2048 + c];
            const float rp = yget(yseg, carry_prev, seg, tl - 1, RW0 + c), kp = yget(yseg, carry_prev, seg, tl - 1, RW0 + 1024 + c), vp = yget(yseg, carry_prev, seg, tl - 1, RW0 + 2048 + c);
            const float r = rc + (rp - rc) * mur, k = kc + (kp - kc) * muk, v = vc + (vp - vc) * muv;
            const float wlog = -softplusf_(-(w0c + aw[q])) - 0.5f;
            const float decay = __expf(-__expf(wlog));
            const float a = sigmoidf_(a0c + aa[q]);
            const float kx = k * kkc; const float n2 = wsum(kx * kx); const float kk = kx * rsqrtf(n2 + 1e-6f);
            const float k2 = k * (1.f + (a - 1.f) * kac);
            const float bsum = wsum(r * k2 * rkc);
            float* rec = rrec + ((size_t)tl * 16 + h) * RREC + j;
            rec[0] = decay; rec[64] = -kk; rec[128] = kk * a; rec[192] = k2; rec[256] = r; rec[320] = v;
            bonus[(size_t)tl * 1024 + c] = bsum * v; gate[(size_t)tl * 1024 + c] = ag[q];
        }
    }
}
__device__ void gdn_prep_tile(const Params& p, int seg, int tile) {
    const int tidx = ltid();
    const float* yseg = (const float*)(p.ws + OFF_YSEG);
    const float* carry_prev = (const float*)(p.ws + OFF_CARRY) + (size_t)((seg + 1) & 1) * 3 * NINP;
    const float* cw = p.in[4]; const float* A_log = p.in[5]; const float* dtb = p.in[6];
    float* grec = (float*)(p.ws + OFF_GREC); float* sz = (float*)(p.ws + OFF_SZ);
    const int h = tidx >> 6, l = tidx & 63, tl0 = tile * 16;
    float wq[4][2], wk[4][2], wv[4][2];
#pragma unroll
    for (int j = 0; j < 4; ++j)
#pragma unroll
        for (int e = 0; e < 2; ++e) { const int col = h * 128 + 2 * l + e; wq[j][e] = cw[j * 3072 + col]; wk[j][e] = cw[j * 3072 + 1024 + col]; wv[j][e] = cw[j * 3072 + 2048 + col]; }
    const float nA = -__expf(A_log[h]), db = dtb[h];
#pragma unroll 1
    for (int q = 0; q < 16; ++q) {
        const int tl = tl0 + q;
        float qv[2] = {0.f, 0.f}, kv[2] = {0.f, 0.f}, vv[2] = {0.f, 0.f};
#pragma unroll
        for (int j = 0; j < 4; ++j)
#pragma unroll
            for (int e = 0; e < 2; ++e) { const int col = h * 128 + 2 * l + e; const int ts = tl - 3 + j;
                qv[e] += wq[j][e] * yget(yseg, carry_prev, seg, ts, col); kv[e] += wk[j][e] * yget(yseg, carry_prev, seg, ts, 1024 + col); vv[e] += wv[j][e] * yget(yseg, carry_prev, seg, ts, 2048 + col); }
#pragma unroll
        for (int e = 0; e < 2; ++e) { qv[e] = siluf_(qv[e]); kv[e] = siluf_(kv[e]); vv[e] = siluf_(vv[e]); }
        const float qn = wsum(qv[0] * qv[0] + qv[1] * qv[1]), kn = wsum(kv[0] * kv[0] + kv[1] * kv[1]);
        const float qs = rsqrtf(qn + 1e-6f) * 0.08838834764831845f, ks = rsqrtf(kn + 1e-6f);
        float* rec = grec + ((size_t)tl * 8 + h) * GREC;
        *(float2*)(rec + 2 * l) = make_float2(qv[0] * qs, qv[1] * qs);
        *(float2*)(rec + 128 + 2 * l) = make_float2(kv[0] * ks, kv[1] * ks);
        *(float2*)(rec + 256 + 2 * l) = make_float2(vv[0], vv[1]);
        if (l == 0) { const float adt = yseg[(size_t)tl * NINP + 4096 + h], bb = yseg[(size_t)tl * NINP + 4104 + h];
            const float g = nA * softplusf_(adt + db); rec[384] = __expf(g); rec[385] = sigmoidf_(bb); rec[386] = 0.f; rec[387] = 0.f; }
        const float2 z = *(const float2*)(yseg + (size_t)tl * NINP + 3072 + h * 128 + 2 * l);
        *(float2*)(sz + (size_t)tl * 1024 + h * 128 + 2 * l) = make_float2(siluf_(z.x), siluf_(z.y));
    }
}

__device__ void rwkv_scan(const Params& p, int seg, int hb, float* lds) {
    const int tidx = ltid();
    const float* rrec = (const float*)(p.ws + OFF_RREC); float* orw = (float*)(p.ws + OFF_ORW); float* SR = (float*)(p.ws + OFF_SR);
    const int tid = tidx, wave = tid >> 6, lane = tid & 63, head = hb >> 2, rq = hb & 3;
    const int row = rq * 16 + (wave & 3) * 4 + (lane >> 4), j = lane & 15;
    constexpr int TS = 32, TF = TS * RREC;
    float4 S = make_float4(0.f, 0.f, 0.f, 0.f);
    if (wave < 4 && seg > 0) S = *(const float4*)(SR + ((size_t)head * 64 + row) * 64 + 4 * j);
    float4 rg0, rg1, rg2, rg3, rg4, rg5;
#define RW_GL(R, i, tile_) { const int e = tid + (i) * 512, st = e / 96, off = e % 96; R = *(const float4*)(rrec + ((size_t)((tile_) * TS + st) * 16 + head) * RREC + off * 4); }
#define RW_GLOAD(tile_) { RW_GL(rg0, 0, tile_) RW_GL(rg1, 1, tile_) RW_GL(rg2, 2, tile_) RW_GL(rg3, 3, tile_) RW_GL(rg4, 4, tile_) RW_GL(rg5, 5, tile_) }
#define RW_LS(R, i, buf_) { *(float4*)(lds + (buf_) * TF + (tid + (i) * 512) * 4) = R; }
#define RW_LSTORE(buf_) { RW_LS(rg0, 0, buf_) RW_LS(rg1, 1, buf_) RW_LS(rg2, 2, buf_) RW_LS(rg3, 3, buf_) RW_LS(rg4, 4, buf_) RW_LS(rg5, 5, buf_) }
    __syncthreads();
    RW_GLOAD(0); RW_LSTORE(0); __syncthreads();
    int cur = 0;
    for (int tile = 0; tile < SEG / TS; ++tile) {
        const int ntile = (tile + 1 < SEG / TS) ? tile + 1 : tile;
        RW_GLOAD(ntile);
        if (wave < 4) {
            const float* base = lds + cur * TF;
#pragma unroll 4
            for (int st = 0; st < TS; ++st, base += RREC) {
                const float4 w4 = *(const float4*)(base + 4 * j), a4 = *(const float4*)(base + 64 + 4 * j), b4 = *(const float4*)(base + 128 + 4 * j);
                const float4 k4 = *(const float4*)(base + 192 + 4 * j), r4 = *(const float4*)(base + 256 + 4 * j); const float vv = base[320 + row];
                float sa = (S.x * a4.x + S.y * a4.y) + (S.z * a4.z + S.w * a4.w);
                sa = allred16(sa);
                S.x = S.x * w4.x + (sa * b4.x + vv * k4.x); S.y = S.y * w4.y + (sa * b4.y + vv * k4.y);
                S.z = S.z * w4.z + (sa * b4.z + vv * k4.z); S.w = S.w * w4.w + (sa * b4.w + vv * k4.w);
                float o = (S.x * r4.x + S.y * r4.y) + (S.z * r4.z + S.w * r4.w);
                o = allred16(o);
                if (j == 0) orw[(size_t)(tile * TS + st) * 1024 + head * 64 + row] = o;
            }
        }
        RW_LSTORE(cur ^ 1);
        __syncthreads();
        cur ^= 1;
    }
#undef RW_GL
#undef RW_GLOAD
#undef RW_LS
#undef RW_LSTORE
    if (wave < 4) *(float4*)(SR + ((size_t)head * 64 + row) * 64 + 4 * j) = S;
}
__device__ void gdn_scan_naive(const Params& p, int seg, int gb, float* lds) {
    const int tidx = ltid();
    const float* grec = (const float*)(p.ws + OFF_GREC); float* ogd = (float*)(p.ws + OFF_OGD); float* SG = (float*)(p.ws + OFF_SG);
    const int tid = tidx, wave = tid >> 6, lane = tid & 63, head = gb >> 1, col = (gb & 1) * 64 + lane;
    constexpr int TS = 32, TF4 = TS * 97;
    float S[128];
#pragma unroll
    for (int i = 0; i < 128; ++i) S[i] = 0.f;
    if (wave == 0 && seg > 0) {
#pragma unroll
        for (int i = 0; i < 128; ++i) S[i] = SG[((size_t)head * 128 + i) * 128 + col];
    }
    float4 gg0, gg1, gg2, gg3, gg4, gg5, gg6;
#define GD_GL(R, i, tile_) { const int e = tid + (i) * 512; if (e < TF4) { const int st = e / 97, off = e % 97; R = *(const float4*)(grec + ((size_t)((tile_) * TS + st) * 8 + head) * GREC + off * 4); } }
#define GD_GLOAD(tile_) { GD_GL(gg0, 0, tile_) GD_GL(gg1, 1, tile_) GD_GL(gg2, 2, tile_) GD_GL(gg3, 3, tile_) GD_GL(gg4, 4, tile_) GD_GL(gg5, 5, tile_) GD_GL(gg6, 6, tile_) }
#define GD_LS(R, i, buf_) { const int e = tid + (i) * 512; if (e < TF4) *(float4*)(lds + (size_t)(buf_) * TF4 * 4 + e * 4) = R; }
#define GD_LSTORE(buf_) { GD_LS(gg0, 0, buf_) GD_LS(gg1, 1, buf_) GD_LS(gg2, 2, buf_) GD_LS(gg3, 3, buf_) GD_LS(gg4, 4, buf_) GD_LS(gg5, 5, buf_) GD_LS(gg6, 6, buf_) }
    gg0 = gg1 = gg2 = gg3 = gg4 = gg5 = gg6 = make_float4(0.f, 0.f, 0.f, 0.f);
    __syncthreads();
    GD_GLOAD(0); GD_LSTORE(0); __syncthreads();
    int cur = 0;
    for (int tile = 0; tile < SEG / TS; ++tile) {
        { const int ntile = (tile + 1 < SEG / TS) ? tile + 1 : tile; GD_GLOAD(ntile); }
        if (wave == 0) {
            const float* base = lds + (size_t)cur * TF4 * 4;
#pragma unroll 1
            for (int st = 0; st < TS; ++st, base += GREC) {
                const float a = base[384], bt = base[385];
                float kS0 = 0.f, kS1 = 0.f;
#pragma unroll
                for (int i = 0; i < 32; ++i) { if ((i & 7) == 0) __builtin_amdgcn_sched_barrier(0); const float4 k4 = *(const float4*)(base + 128 + 4 * i); kS0 += k4.x * S[4 * i] + k4.z * S[4 * i + 2]; kS1 += k4.y * S[4 * i + 1] + k4.w * S[4 * i + 3]; }
                const float u = bt * (base[256 + col] - a * (kS0 + kS1));
                float o0 = 0.f, o1 = 0.f;
#pragma unroll
                for (int i = 0; i < 32; ++i) { if ((i & 3) == 0) __builtin_amdgcn_sched_barrier(0); const float4 k4 = *(const float4*)(base + 128 + 4 * i); const float4 q4 = *(const float4*)(base + 4 * i);
                    S[4 * i] = a * S[4 * i] + k4.x * u; S[4 * i + 1] = a * S[4 * i + 1] + k4.y * u; S[4 * i + 2] = a * S[4 * i + 2] + k4.z * u; S[4 * i + 3] = a * S[4 * i + 3] + k4.w * u;
                    o0 += q4.x * S[4 * i] + q4.z * S[4 * i + 2]; o1 += q4.y * S[4 * i + 1] + q4.w * S[4 * i + 3]; }
                ogd[(size_t)(tile * TS + st) * 1024 + head * 128 + col] = o0 + o1;
            }
        }
        GD_LSTORE(cur ^ 1);
        __syncthreads();
        cur ^= 1;
    }
    if (wave == 0) {
#pragma unroll
        for (int i = 0; i < 128; ++i) SG[((size_t)head * 128 + i) * 128 + col] = S[i];
    }
}

__device__ void mixer_post(const Params& p, int seg) {
    const int tidx = ltid();
    const float* ogd = (const float*)(p.ws + OFF_OGD); const float* orw = (const float*)(p.ws + OFF_ORW);
    const float* sz = (const float*)(p.ws + OFF_SZ); const float* bonus = (const float*)(p.ws + OFF_BONUS); const float* gate = (const float*)(p.ws + OFF_GATE);
    const float* gnw = p.in[7]; const float* lnw = p.in[17]; const float* lnb = p.in[18];
    bf16_t* mixed = (bf16_t*)(p.ws + OFF_AB1);
    const int gw = blockIdx.x * 8 + (tidx >> 6), nw = gridDim.x * 8, l = tidx & 63;
    const float2 nwv = *(const float2*)(gnw + 2 * l);
    for (int tl = gw; tl < SEG; tl += nw) {
        bf16_t* mrow = mixed + (size_t)(seg * SEG + tl) * 2048;
#pragma unroll 2
        for (int h = 0; h < 8; ++h) {
            const float2 o = *(const float2*)(ogd + (size_t)tl * 1024 + h * 128 + 2 * l);
            const float ss = wsum(o.x * o.x + o.y * o.y); const float rs = rsqrtf(ss * (1.f / 128.f) + 1e-6f);
            const float2 z = *(const float2*)(sz + (size_t)tl * 1024 + h * 128 + 2 * l);
            *(unsigned*)(mrow + h * 128 + 2 * l) = pack2(o.x * rs * nwv.x * z.x, o.y * rs * nwv.y * z.y);
        }
#pragma unroll 2
        for (int h = 0; h < 16; ++h) {
            const int c = h * 64 + l;
            const float o = orw[(size_t)tl * 1024 + c];
            const float mean = wsum(o) * (1.f / 64.f); const float d = o - mean; const float var = wsum(d * d) * (1.f / 64.f);
            const float y = d * rsqrtf(var + 64e-5f) * lnw[c] + lnb[c];
            mrow[1024 + c] = f2bf((y + bonus[(size_t)tl * 1024 + c]) * gate[(size_t)tl * 1024 + c]);
        }
    }
}

#ifndef GM
#define GM 0xFFFFFFFFu
#endif
constexpr unsigned PH_ALL = 0x1FFFu;
template <unsigned PH> __global__ void __launch_bounds__(512, 2) mega(Params p, int seg_lo, int seg_hi) {
    extern __shared__ __attribute__((aligned(16))) unsigned char shm[];
#define SYNC() do { if constexpr (PH == PH_ALL) cg::this_grid().sync(); } while (0)
    LAS unsigned char* lds = (LAS unsigned char*)shm;
    float* ldsf = (float*)shm;
#define WSB (p.ws)
#define WIN ((bf16_t*)(WSB + OFF_WIN))
#define WOUT ((bf16_t*)(WSB + OFF_WOUT))
#define WQ ((bf16_t*)(WSB + OFF_WQ))
#define WK ((bf16_t*)(WSB + OFF_WK))
#define WV ((bf16_t*)(WSB + OFF_WV))
#define WO ((bf16_t*)(WSB + OFF_WO))
#define WUP ((bf16_t*)(WSB + OFF_WUP))
#define WDN ((bf16_t*)(WSB + OFF_WDN))
#define MN ((bf16_t*)(WSB + OFF_MN))
#define KX ((bf16_t*)(WSB + OFF_KX))
#define VT ((bf16_t*)(WSB + OFF_VT))
#define RSTDX ((float*)(WSB + OFF_RSTDX))
#define SSQ1 ((float*)(WSB + OFF_SSQ1))
#define SSQ2 ((float*)(WSB + OFF_SSQ2))
#define PROW ((float*)(WSB + OFF_PROW))
#define AB0 ((bf16_t*)(WSB + OFF_AB0))
#define AB1 ((bf16_t*)(WSB + OFF_AB1))
#define UB ((bf16_t*)(WSB + OFF_U))
#define YSEG ((float*)(WSB + OFF_YSEG))

    if constexpr (PH & 1u) {
    convT(p.in[3], WIN, p.in[2], D, NIN, NINP, ldsf);
    convT(p.in[19], WOUT, nullptr, D, D, D, ldsf);
    convT(p.in[22], WQ, p.in[20], D, D, D, ldsf);
    convT(p.in[23], WK, nullptr, D, D, D, ldsf);
    convT(p.in[24], WV, nullptr, D, D, D, ldsf);
    convT(p.in[25], WO, nullptr, D, D, D, ldsf);
    convT(p.in[27], WUP, p.in[26], D, DFF, DFF, ldsf);
    convT(p.in[28], WDN, nullptr, DFF, D, D, ldsf);
    rows_to_bf16(p.in[0], AB0, RSTDX, nullptr, T);
    rows_to_bf16(p.in[1], MN, nullptr, p.in[21], 256);
    }
    SYNC();

    if constexpr (PH & 0xEu)
    for (int seg = seg_lo; seg < seg_hi; ++seg) {
        if constexpr (PH & 2u) {
        if (seg > 0) mixer_post(p, seg - 1);
        { EpiY e; e.Y = YSEG; e.ldc = NINP; e.rstd = RSTDX + seg * SEG;
          if (GM & (1u << 0)) run_gemm(lds, AB0 + (size_t)seg * SEG * D, WIN, D, D, D, SEG / 256, NINP / 256, 1, 0, 0, e, 0); }
        if (seg == 0) {
            { EpiBf e; e.O = KX; e.ldc = D; e.ssq = nullptr; if (GM & (1u << 1)) run_gemm(lds, MN, WK, D, D, D, 1, 8, 1, 0, 0, e, 16); }
            { EpiBf e; e.O = VT; e.ldc = 256; e.ssq = nullptr; if (GM & (1u << 2)) run_gemm(lds, WV, MN, D, D, D, 8, 1, 1, 0, 0, e, 8); }
        }
        }
        SYNC();
        if constexpr (PH & 4u) {
#ifndef SKIP_RP
        if (blockIdx.x < 128) rwkv_prep_tile(p, seg, blockIdx.x, ldsf);
#endif
#ifndef SKIP_GP
        if (blockIdx.x >= 128) gdn_prep_tile(p, seg, blockIdx.x - 128);
#endif
        if (blockIdx.x == 255) {
            float* carry = (float*)(WSB + OFF_CARRY) + (size_t)(seg & 1) * 3 * NINP;
            for (int i = ltid(); i < 3 * NINP; i += 512) carry[i] = YSEG[(size_t)(SEG - 3) * NINP + i];
        }
        }
        SYNC();
        if constexpr (PH & 8u) {
#ifndef SKIP_GS
        if (blockIdx.x < 16) gdn_scan_naive(p, seg, blockIdx.x, ldsf);
#endif
#ifndef SKIP_RS
        if (blockIdx.x >= 16 && blockIdx.x < 80) rwkv_scan(p, seg, blockIdx.x - 16, ldsf);
#endif
        }
        SYNC();
    }
    if constexpr (PH & 16u) mixer_post(p, NSEG - 1);
    SYNC();
    if constexpr (PH & 32u) { EpiRes e; e.R = p.in[0]; e.H = p.out; e.HB = AB0; e.ssq = SSQ1; if (GM & (1u << 3)) run_gemm(lds, AB1, WOUT, D, D, D, T / 256, 8, 1, 0, 0, e, 0); }
    SYNC();
    if constexpr (PH & 64u) { EpiBf e; e.O = AB1; e.ldc = D; e.ssq = SSQ1; if (GM & (1u << 4)) run_gemm(lds, AB0, WQ, D, D, D, T / 256, 8, 1, 0, 0, e, 0); }
    SYNC();
    if constexpr (PH & 128u) { EpiScore e; e.P = AB0; e.prow = PROW; e.scale = 0.044194173824159216f; if (GM & (1u << 5)) run_gemm(lds, AB1, KX, D, D, 512, T / 256, 1, 4, 512, 512, e, 0); }
    SYNC();
    if constexpr (PH & 256u) { EpiPV e; e.O = AB1; e.prow = PROW; if (GM & (1u << 6)) run_gemm(lds, AB0, VT, 1024, 256, 256, T / 256, 2, 4, 256, (size_t)512 * 256, e, 0); }
    SYNC();
    if constexpr (PH & 512u) { EpiRes e; e.R = p.out; e.H = p.out; e.HB = AB0; e.ssq = SSQ2; if (GM & (1u << 7)) run_gemm(lds, AB1, WO, D, D, D, T / 256, 8, 1, 0, 0, e, 0); }
    SYNC();
    if constexpr (PH & 1024u) { EpiUp e; e.O = UB; e.ldc = DFF; e.ssq = SSQ2; if (GM & (1u << 8)) run_gemm(lds, AB0, WUP, D, D, D, T / 256, DFF / 256, 1, 0, 0, e, 0); }
    SYNC();
    if constexpr (PH & 2048u) { EpiRes e; e.R = p.out; e.H = p.out; e.HB = nullptr; e.ssq = nullptr; if (GM & (1u << 9)) run_gemm(lds, UB, WDN, DFF, DFF, DFF, T / 256, 8, 1, 0, 0, e, 0); }
    SYNC();
    if constexpr (PH & 4096u) {
        const float* gain = p.in[29];
        const int tidx = ltid(); const int gw = blockIdx.x * 8 + (tidx >> 6), nw = gridDim.x * 8, lane = tidx & 63;
        for (int r = gw; r < T; r += nw) {
            float4* pr = (float4*)(p.out + (size_t)r * 2048);
            float4 v[8]; float ss = 0.f;
#pragma unroll
            for (int i = 0; i < 8; ++i) { v[i] = pr[i * 64 + lane]; ss += v[i].x * v[i].x + v[i].y * v[i].y + v[i].z * v[i].z + v[i].w * v[i].w; }
            ss = wsum(ss); const float rs = rsqrtf(ss * (1.f / 2048.f) + 1e-6f);
#pragma unroll
            for (int i = 0; i < 8; ++i) { const float4 gg = ((const float4*)gain)[i * 64 + lane]; float4 w = v[i]; w.x *= rs * gg.x; w.y *= rs * gg.y; w.z *= rs * gg.z; w.w *= rs * gg.w; pr[i * 64 + lane] = w; }
        }
    }
}

extern "C" void kernel_launch(void* const* d_in, const int* in_sizes, int n_in, void* d_out, int out_size, void* d_ws, size_t ws_size, hipStream_t stream) {
    Params p{};
    for (int i = 0; i < 30; ++i) p.in[i] = (const float*)d_in[i];
    p.out = (float*)d_out; p.ws = (unsigned char*)d_ws;
#ifdef ONE_LAUNCH
    static int grid_blocks = 0;
    if (!grid_blocks) {
        (void)hipFuncSetAttribute((const void*)mega<PH_ALL>, hipFuncAttributeMaxDynamicSharedMemorySize, LDS_BYTES);
        int dev = 0, cus = 0, per_cu = 0;
        (void)hipGetDevice(&dev);
        (void)hipDeviceGetAttribute(&cus, hipDeviceAttributeMultiprocessorCount, dev);
        (void)hipOccupancyMaxActiveBlocksPerMultiprocessor(&per_cu, mega<PH_ALL>, 512, LDS_BYTES);
        grid_blocks = (cus * per_cu >= 256) ? 256 : cus * per_cu;
    }
    int lo = 0, hi = NSEG;
    void* args[] = {&p, &lo, &hi};
    hipError_t e = hipLaunchCooperativeKernel((void*)mega<PH_ALL>, dim3(grid_blocks), dim3(512), args, LDS_BYTES, stream);
    if (e != hipSuccess) fprintf(stderr, "cooperative launch failed: %s (grid %d)\n", hipGetErrorString(e), grid_blocks);
#else
    static int init = 0;
#define SETA(PHV) (void)hipFuncSetAttribute((const void*)mega<PHV>, hipFuncAttributeMaxDynamicSharedMemorySize, LDS_BYTES)
    if (!init) { init = 1; SETA(1u); SETA(2u); SETA(4u); SETA(8u); SETA(16u); SETA(32u); SETA(64u); SETA(128u); SETA(256u); SETA(512u); SETA(1024u); SETA(2048u); SETA(4096u); }
#define L(PHV, lo, hi) mega<PHV><<<256, 512, LDS_BYTES, stream>>>(p, lo, hi)
    L(1u, 0, 0);
    for (int s = 0; s < NSEG; ++s) { L(2u, s, s + 1); L(4u, s, s + 1); L(8u, s, s + 1); }
    L(16u, 0, 0); L(32u, 0, 0); L(64u, 0, 0); L(128u, 0, 0); L(256u, 0, 0); L(512u, 0, 0); L(1024u, 0, 0); L(2048u, 0, 0); L(4096u, 0, 0);
#endif
}
```

```cpp
#include <hip/hip_runtime.h>
#include <hip/hip_cooperative_groups.h>
#include <cstdio>
namespace cg = cooperative_groups;

#define LAS __attribute__((address_space(3)))
typedef unsigned short bf16_t;
typedef short bf16x8 __attribute__((ext_vector_type(8)));
typedef float f32x4 __attribute__((ext_vector_type(4)));

constexpr int T = 16384, D = 2048, NIN = 7472, NINP = 7680, DFF = 8192;
constexpr int GDN_COLS = 4112, RW0 = 4112;
constexpr int SEG = 2048, NSEG = 8;
constexpr int RREC = 384, GREC = 388;

constexpr size_t al(size_t x) { return (x + 255) & ~(size_t)255; }
constexpr size_t OFF_WIN = 0;
constexpr size_t OFF_WOUT = OFF_WIN + (size_t)NINP * D * 2;
constexpr size_t OFF_WQ = OFF_WOUT + (size_t)D * D * 2;
constexpr size_t OFF_WK = OFF_WQ + (size_t)D * D * 2;
constexpr size_t OFF_WV = OFF_WK + (size_t)D * D * 2;
constexpr size_t OFF_WO = OFF_WV + (size_t)D * D * 2;
constexpr size_t OFF_WUP = OFF_WO + (size_t)D * D * 2;
constexpr size_t OFF_WDN = OFF_WUP + (size_t)DFF * D * 2;
constexpr size_t OFF_MN = OFF_WDN + (size_t)DFF * D * 2;
constexpr size_t OFF_KX = OFF_MN + (size_t)256 * D * 2;
constexpr size_t OFF_VT = OFF_KX + (size_t)256 * D * 2;
constexpr size_t OFF_RSTDX = OFF_VT + (size_t)256 * D * 2;
constexpr size_t OFF_SSQ1 = OFF_RSTDX + (size_t)T * 4;
constexpr size_t OFF_SSQ2 = OFF_SSQ1 + (size_t)T * 32 * 4;
constexpr size_t OFF_PROW = OFF_SSQ2 + (size_t)T * 32 * 4;
constexpr size_t OFF_CARRY = OFF_PROW + (size_t)T * 16 * 4;
constexpr size_t OFF_SG = OFF_CARRY + al((size_t)2 * 3 * NINP * 4);
constexpr size_t OFF_SR = OFF_SG + (size_t)8 * 128 * 128 * 4;
constexpr size_t OFF_AB0 = OFF_SR + (size_t)16 * 64 * 64 * 4;
constexpr size_t OFF_AB1 = OFF_AB0 + (size_t)T * D * 2;
constexpr size_t OFF_BIG = OFF_AB1 + (size_t)T * D * 2;
constexpr size_t OFF_YSEG = OFF_BIG;
constexpr size_t OFF_RREC = OFF_YSEG + (size_t)SEG * NINP * 4;
constexpr size_t OFF_GREC = OFF_RREC + (size_t)SEG * 16 * RREC * 4;
constexpr int NTASK = (SEG / 64) * 8;
constexpr size_t OFF_PM = OFF_GREC;
constexpr size_t OFF_RN = OFF_PM + (size_t)NTASK * 16384 * 2;
constexpr size_t OFF_QP = OFF_RN + (size_t)NTASK * 16384 * 4;
constexpr size_t OFF_OL = OFF_QP + (size_t)NTASK * 8192 * 2;
constexpr size_t OFF_SH = OFF_OL + (size_t)NTASK * 8192 * 4;
constexpr size_t OFF_EG = OFF_SH + (size_t)NTASK * 16384 * 2;
constexpr size_t OFF_UW = OFF_EG + 4096;
constexpr size_t OFF_BONUS = OFF_UW + (size_t)NTASK * 16384 * 4;
constexpr size_t OFF_GATE = OFF_BONUS + (size_t)SEG * 1024 * 4;
constexpr size_t OFF_SZ = OFF_GATE + (size_t)SEG * 1024 * 4;
constexpr size_t OFF_ORW = OFF_SZ + (size_t)SEG * 1024 * 4;
constexpr size_t OFF_OGD = OFF_ORW + (size_t)SEG * 1024 * 4;
constexpr size_t OFF_END1 = OFF_OGD + (size_t)SEG * 1024 * 4;
constexpr size_t OFF_U = OFF_AB1;
constexpr size_t OFF_END2 = OFF_U + (size_t)T * DFF * 2;
static_assert(OFF_END1 <= 536870912ull, "ws overflow 1");
static_assert(OFF_END2 <= 536870912ull, "ws overflow 2");

constexpr int LDS_BYTES = 163840;
constexpr int GP_SM = 0, GP_MM = 1024, GP_AM = 17408, GP_QF = 33792, GP_KF = 67584, GP_VF = 101376, GP_KTT = 135168, GP_AB = 153600;

struct Params {
    const float* in[30];
    float* out;
    unsigned char* ws;
};

__device__ __forceinline__ bf16_t f2bf(float f) { unsigned u = __float_as_uint(f); u += 0x7FFFu + ((u >> 16) & 1u); return (bf16_t)(u >> 16); }
__device__ __forceinline__ unsigned pack2(float a, float b) { return (unsigned)f2bf(a) | ((unsigned)f2bf(b) << 16); }
__device__ __forceinline__ float wsum(float v) {
#pragma unroll
    for (int o = 32; o > 0; o >>= 1) v += __shfl_xor(v, o);
    return v;
}
__device__ __forceinline__ float sigmoidf_(float x) { return 1.f / (1.f + __expf(-x)); }
__device__ __forceinline__ float softplusf_(float x) { return x > 20.f ? x : log1pf(__expf(x)); }
__device__ __forceinline__ float siluf_(float x) { return x / (1.f + __expf(-x)); }
template <int CTRL> __device__ __forceinline__ float dppf(float x) { return __int_as_float(__builtin_amdgcn_update_dpp(0, __float_as_int(x), CTRL, 0xF, 0xF, false)); }
__device__ __forceinline__ float allred16(float x) {
    x += dppf<0xB1>(x);
    x += dppf<0x4E>(x);
    x += dppf<0x124>(x);
    x += dppf<0x128>(x);
    return x;
}

__device__ __forceinline__ int ltid() { int t = threadIdx.x; asm volatile("" : "+v"(t)); return t; }

namespace pg8 {
constexpr int BM = 256, BK = 64, HALF = 128, HTB = HALF * BK * 2, NXCD = 8, WGM = 8;
__device__ __forceinline__ int lds_byte(int r, int c) { const int st = (r >> 4) * 2 + (c >> 5), rr = r & 15, cc = c & 31, ob = rr * 64 + cc * 2; return st * 1024 + (ob ^ (((ob >> 9) & 1) << 5)); }
__device__ __forceinline__ void stage_rc(int b, int& R, int& C) { const int st = b / 1024, sb = b % 1024, swz = sb ^ (((sb >> 9) & 1) << 5); R = (st >> 1) * 16 + swz / 64; C = (st & 1) * 32 + (swz % 64) / 2; }

struct Unit { int pm, pn, b; };
struct Gemm { const bf16_t* A; const bf16_t* Bt; int lda, ldb, K, nM, nN, nB; size_t sA, sB; };

struct Order {
    int nM, nN, per, nwg, G, c;
    __device__ void init(const Gemm& g, int G_, int c_) { nM = g.nM; nN = g.nN; per = nM * nN; nwg = per * g.nB; G = G_; c = c_; }
    __device__ bool next(int i, Unit& u) const {
        const long L = (long)i * G + c; if (L >= nwg) return false;
        u.b = (int)(L / per); int wgid = (int)(L % per);
        { const int q = per / NXCD, r = per % NXCD, xcd = wgid % NXCD, off = wgid / NXCD; wgid = (xcd < r ? xcd * (q + 1) : r * (q + 1) + (xcd - r) * q) + off; }
        const int nig = WGM * nN, gid = wgid / nig, fm = gid * WGM, gsz = (nM - fm) < WGM ? (nM - fm) : WGM;
        u.pm = fm + ((wgid % nig) % gsz); u.pn = (wgid % nig) / gsz; return true;
    }
};

template <class Epi>
__device__ __forceinline__ void gemm_phase(LAS unsigned char* lds, const Gemm g, const Order& S, const Epi& E) {
    int tid_ = threadIdx.x; asm volatile("" : "+v"(tid_));
    const int tid = tid_, wid = __builtin_amdgcn_readfirstlane(tid >> 6), lane = tid & 63, wr = wid >> 2, wc = wid & 3, fr = lane & 15, fq = lane >> 4;
    const int K = g.K, nt = K / BK;
    unsigned voffA[2], voffB[2];
#pragma unroll
    for (int i = 0; i < 2; ++i) { int R, C; stage_rc(tid * 16 + i * 8192, R, C);
        voffA[i] = (unsigned)(R * g.lda + C) * 2u; voffB[i] = (unsigned)(R * g.ldb + C) * 2u; }
    const size_t kstep = (size_t)(BK * 2);
    const size_t hstepA = (size_t)HALF * g.lda * 2, hstepB = (size_t)HALF * g.ldb * 2;
    const size_t tstepA = 2 * hstepA, tstepB = 2 * hstepB;
    const unsigned ldsw = (unsigned)wid * 1024u;
    const int aoff = lds_byte(wr * 64 + fr, fq * 8), boff = lds_byte(wc * 32 + fr, fq * 8);
#define PG8_SA(b, h) (((b) * 2 + (h)) * HTB)
#define PG8_SB(b, h) ((4 + (b) * 2 + (h)) * HTB)
#define PG8_STAGE(bufoff, gbase, voff) do { _Pragma("unroll") for (int _i = 0; _i < 2; ++_i) \
        __builtin_amdgcn_global_load_lds((const unsigned*)((const char*)(gbase) + (voff)[_i]), (LAS unsigned*)(lds + (bufoff) + ldsw + _i * 8192), 16, 0, 0); } while (0)
#define PG8_LDA(dst, b, h) do { _Pragma("unroll") for (int m = 0; m < 4; ++m) _Pragma("unroll") for (int k = 0; k < 2; ++k) dst[m][k] = *(const LAS bf16x8*)(lds + PG8_SA(b, h) + aoff + m * 2048 + k * 1024); } while (0)
#define PG8_LDB(dst, b, h) do { _Pragma("unroll") for (int n = 0; n < 2; ++n) _Pragma("unroll") for (int k = 0; k < 2; ++k) dst[n][k] = *(const LAS bf16x8*)(lds + PG8_SB(b, h) + boff + n * 2048 + k * 1024); } while (0)
#define PG8_MMA(ai, bj, At, Bt) do { __builtin_amdgcn_s_setprio(1); _Pragma("unroll") for (int m = 0; m < 4; ++m) _Pragma("unroll") for (int n = 0; n < 2; ++n) _Pragma("unroll") for (int k = 0; k < 2; ++k) \
        acc[ai][bj][m][n] = __builtin_amdgcn_mfma_f32_16x16x32_bf16(Bt[n][k], At[m][k], acc[ai][bj][m][n], 0, 0, 0); __builtin_amdgcn_s_setprio(0); } while (0)
#define PG8_WAIT_V(n) asm volatile("s_waitcnt vmcnt(" #n ")" ::: "memory")
#define PG8_WAIT_L(n) asm volatile("s_waitcnt lgkmcnt(" #n ")" ::: "memory")
#define PG8_BAR __builtin_amdgcn_s_barrier()
#define PG8_SCHED __builtin_amdgcn_sched_barrier(0)
    Unit cur, nxt; int ui = 0;
    if (!S.next(0, cur)) return;
    f32x4 acc[2][2][4][2];
#pragma unroll
    for (int a = 0; a < 2; ++a)
#pragma unroll
        for (int b = 0; b < 2; ++b)
#pragma unroll
            for (int m = 0; m < 4; ++m)
#pragma unroll
                for (int n = 0; n < 2; ++n) acc[a][b][m][n] = (f32x4){0.f, 0.f, 0.f, 0.f};
    bf16x8 At[4][2], B0[2][2], B1[2][2];
    const char* cA = (const char*)g.A + (size_t)cur.b * g.sA * 2 + (size_t)cur.pm * tstepA; const char* cB = (const char*)g.Bt + (size_t)cur.b * g.sB * 2 + (size_t)cur.pn * tstepB;
    PG8_STAGE(PG8_SB(0, 0), cB, voffB); PG8_STAGE(PG8_SA(0, 0), cA, voffA); PG8_STAGE(PG8_SB(0, 1), cB + hstepB, voffB); PG8_STAGE(PG8_SA(0, 1), cA + hstepA, voffA);
    if (wr == 1) PG8_BAR;
    PG8_WAIT_V(4); PG8_BAR;
    PG8_STAGE(PG8_SB(1, 0), cB + kstep, voffB); PG8_STAGE(PG8_SA(1, 0), cA + kstep, voffA); PG8_STAGE(PG8_SB(1, 1), cB + hstepB + kstep, voffB);
    PG8_WAIT_V(6); PG8_BAR;
    for (;;) {
        const bool has_next = S.next(ui + 1, nxt);
        const char* nA = has_next ? (const char*)g.A + (size_t)nxt.b * g.sA * 2 + (size_t)nxt.pm * tstepA : cA; const char* nB = has_next ? (const char*)g.Bt + (size_t)nxt.b * g.sB * 2 + (size_t)nxt.pn * tstepB : cB;
        for (int t = 0; t < nt; t += 2) {
            const bool last = (t == nt - 2);
            const char* a1 = cA + (size_t)(t + 1) * kstep;
            const char* a2 = last ? nA : cA + (size_t)(t + 2) * kstep; const char* b2 = last ? nB : cB + (size_t)(t + 2) * kstep;
            const char* a3 = a2 + kstep; const char* b3 = b2 + kstep;
            PG8_LDB(B0, 0, 0); PG8_SCHED; PG8_LDA(At, 0, 0); PG8_STAGE(PG8_SA(1, 1), a1 + hstepA, voffA);
            PG8_WAIT_L(8); PG8_BAR; PG8_WAIT_L(0); PG8_MMA(0, 0, At, B0); PG8_BAR; PG8_SCHED;
            PG8_LDB(B1, 0, 1); PG8_STAGE(PG8_SB(0, 0), b2, voffB);
            PG8_BAR; PG8_WAIT_L(0); PG8_MMA(0, 1, At, B1); PG8_BAR;
            PG8_LDA(At, 0, 1); PG8_STAGE(PG8_SA(0, 0), a2, voffA);
            PG8_BAR; PG8_WAIT_L(0); PG8_MMA(1, 0, At, B0); PG8_BAR; PG8_SCHED;
            PG8_STAGE(PG8_SB(0, 1), b2 + hstepB, voffB);
            PG8_WAIT_V(6); PG8_BAR; PG8_MMA(1, 1, At, B1); PG8_BAR;
            PG8_LDB(B0, 1, 0); PG8_SCHED; PG8_LDA(At, 1, 0); PG8_STAGE(PG8_SA(0, 1), a2 + hstepA, voffA);
            PG8_WAIT_L(8); PG8_BAR; PG8_WAIT_L(0); PG8_MMA(0, 0, At, B0); PG8_BAR; PG8_SCHED;
            PG8_LDB(B1, 1, 1); PG8_STAGE(PG8_SB(1, 0), b3, voffB);
            PG8_BAR; PG8_WAIT_L(0); PG8_MMA(0, 1, At, B1); PG8_BAR;
            PG8_LDA(At, 1, 1); PG8_STAGE(PG8_SA(1, 0), a3, voffA);
            PG8_BAR; PG8_WAIT_L(0); PG8_MMA(1, 0, At, B0); PG8_BAR; PG8_SCHED;
            PG8_STAGE(PG8_SB(1, 1), b3 + hstepB, voffB);
            PG8_WAIT_V(6); PG8_BAR; PG8_MMA(1, 1, At, B1); PG8_BAR;
        }
        E(acc, cur, wr, wc, fr, fq);
        if (!has_next) break;
#pragma unroll
        for (int a = 0; a < 2; ++a)
#pragma unroll
            for (int b = 0; b < 2; ++b)
#pragma unroll
                for (int m = 0; m < 4; ++m)
#pragma unroll
                    for (int n = 0; n < 2; ++n) acc[a][b][m][n] = (f32x4){0.f, 0.f, 0.f, 0.f};
        cur = nxt; cA = nA; cB = nB; ++ui;
    }
    PG8_WAIT_V(0);
    if (wr == 0) PG8_BAR;
    PG8_BAR;
#undef PG8_SA
#undef PG8_SB
#undef PG8_STAGE
#undef PG8_LDA
#undef PG8_LDB
#undef PG8_MMA
#undef PG8_WAIT_V
#undef PG8_WAIT_L
#undef PG8_BAR
#undef PG8_SCHED
}
}
using pg8::Unit;
using pg8::Gemm;

__device__ __forceinline__ float rs_from(const float* ssq, int row) {
    const float4* p = (const float4*)(ssq + (size_t)row * 32); float s = 0.f;
#pragma unroll
    for (int i = 0; i < 8; ++i) { float4 v = p[i]; s += (v.x + v.y) + (v.z + v.w); }
    return rsqrtf(s * (1.f / 2048.f) + 1e-6f);
}
struct EpiY {
    float* Y; int ldc; const float* rstd;
    __device__ __forceinline__ void operator()(const f32x4 (&acc)[2][2][4][2], const Unit& u, int wr, int wc, int fr, int fq) const {
        const int row0 = u.pm * 256 + wr * 64 + fr, col0 = u.pn * 256 + wc * 32 + 4 * fq;
#pragma unroll
        for (int ai = 0; ai < 2; ++ai)
#pragma unroll
            for (int m = 0; m < 4; ++m) { __builtin_amdgcn_sched_barrier(0); const int row = row0 + ai * 128 + m * 16; const float rs = rstd ? rstd[row] : 1.f; float* rowp = Y + (size_t)row * ldc + col0;
#pragma unroll
                for (int bj = 0; bj < 2; ++bj)
#pragma unroll
                    for (int n = 0; n < 2; ++n) *(f32x4*)(rowp + bj * 128 + n * 16) = acc[ai][bj][m][n] * rs; }
    }
};
struct EpiBf {
    bf16_t* O; int ldc; const float* ssq;
    __device__ __forceinline__ void operator()(const f32x4 (&acc)[2][2][4][2], const Unit& u, int wr, int wc, int fr, int fq) const {
        const int row0 = u.pm * 256 + wr * 64 + fr, col0 = u.pn * 256 + wc * 32 + 4 * fq;
#pragma unroll
        for (int ai = 0; ai < 2; ++ai)
#pragma unroll
            for (int m = 0; m < 4; ++m) { __builtin_amdgcn_sched_barrier(0); const int row = row0 + ai * 128 + m * 16; const float rs = ssq ? rs_from(ssq, row) : 1.f; bf16_t* rowp = O + (size_t)row * ldc + col0;
#pragma unroll
                for (int bj = 0; bj < 2; ++bj)
#pragma unroll
                    for (int n = 0; n < 2; ++n) { f32x4 v = acc[ai][bj][m][n] * rs; uint2 o; o.x = pack2(v[0], v[1]); o.y = pack2(v[2], v[3]); *(uint2*)(rowp + bj * 128 + n * 16) = o; } }
    }
};
struct EpiUp {
    bf16_t* O; int ldc; const float* ssq;
    __device__ __forceinline__ void operator()(const f32x4 (&acc)[2][2][4][2], const Unit& u, int wr, int wc, int fr, int fq) const {
        const int row0 = u.pm * 256 + wr * 64 + fr, col0 = u.pn * 256 + wc * 32 + 4 * fq;
#pragma unroll
        for (int ai = 0; ai < 2; ++ai)
#pragma unroll
            for (int m = 0; m < 4; ++m) { __builtin_amdgcn_sched_barrier(0); const int row = row0 + ai * 128 + m * 16; const float rs = rs_from(ssq, row); bf16_t* rowp = O + (size_t)row * ldc + col0;
#pragma unroll
                for (int bj = 0; bj < 2; ++bj)
#pragma unroll
                    for (int n = 0; n < 2; ++n) { f32x4 v = acc[ai][bj][m][n] * rs;
                        float a = fmaxf(v[0], 0.f), b = fmaxf(v[1], 0.f), c = fmaxf(v[2], 0.f), d = fmaxf(v[3], 0.f);
                        uint2 o; o.x = pack2(a * a, b * b); o.y = pack2(c * c, d * d); *(uint2*)(rowp + bj * 128 + n * 16) = o; } }
    }
};
struct EpiRes {
    const float* R; float* H; bf16_t* HB; float* ssq;
    __device__ __forceinline__ void operator()(const f32x4 (&acc)[2][2][4][2], const Unit& u, int wr, int wc, int fr, int fq) const {
        const int row0 = u.pm * 256 + wr * 64 + fr, col0 = u.pn * 256 + wc * 32 + 4 * fq;
#pragma unroll
        for (int ai = 0; ai < 2; ++ai)
#pragma unroll
            for (int m = 0; m < 4; ++m) { __builtin_amdgcn_sched_barrier(0); const int row = row0 + ai * 128 + m * 16; const size_t ro = (size_t)row * 2048 + col0; float s = 0.f;
#pragma unroll
                for (int bj = 0; bj < 2; ++bj)
#pragma unroll
                    for (int n = 0; n < 2; ++n) { const size_t o = ro + bj * 128 + n * 16; f32x4 v = acc[ai][bj][m][n] + *(const f32x4*)(R + o); *(f32x4*)(H + o) = v;
                        s += v[0] * v[0] + v[1] * v[1] + v[2] * v[2] + v[3] * v[3];
                        if (HB) { uint2 pk; pk.x = pack2(v[0], v[1]); pk.y = pack2(v[2], v[3]); *(uint2*)(HB + o) = pk; } }
                if (ssq) { s += __shfl_xor(s, 16); s += __shfl_xor(s, 32); if (fq == 0) ssq[(size_t)row * 32 + u.pn * 4 + wc] = s; } }
    }
};
struct EpiScore {
    bf16_t* P; float* prow; float scale;
    __device__ __forceinline__ void operator()(const f32x4 (&acc)[2][2][4][2], const Unit& u, int wr, int wc, int fr, int fq) const {
        const int row0 = u.pm * 256 + wr * 64 + fr, col0 = u.b * 256 + wc * 32 + 4 * fq;
#pragma unroll
        for (int ai = 0; ai < 2; ++ai)
#pragma unroll
            for (int m = 0; m < 4; ++m) { __builtin_amdgcn_sched_barrier(0); const int row = row0 + ai * 128 + m * 16; bf16_t* rowp = P + (size_t)row * 1024 + col0; float s = 0.f;
#pragma unroll
                for (int bj = 0; bj < 2; ++bj)
#pragma unroll
                    for (int n = 0; n < 2; ++n) { f32x4 v = acc[ai][bj][m][n] * scale;
                        float a = __expf(fminf(v[0], 80.f)), b = __expf(fminf(v[1], 80.f)), c = __expf(fminf(v[2], 80.f)), d = __expf(fminf(v[3], 80.f));
                        s += (a + b) + (c + d); uint2 o; o.x = pack2(a, b); o.y = pack2(c, d); *(uint2*)(rowp + bj * 128 + n * 16) = o; }
                s += __shfl_xor(s, 16); s += __shfl_xor(s, 32); if (fq == 0) prow[(size_t)row * 16 + u.b * 4 + wc] = s; }
    }
};
struct EpiPV {
    bf16_t* O; const float* prow;
    __device__ __forceinline__ void operator()(const f32x4 (&acc)[2][2][4][2], const Unit& u, int wr, int wc, int fr, int fq) const {
        const int row0 = u.pm * 256 + wr * 64 + fr, col0 = u.b * 512 + u.pn * 256 + wc * 32 + 4 * fq;
#pragma unroll
        for (int ai = 0; ai < 2; ++ai)
#pragma unroll
            for (int m = 0; m < 4; ++m) { __builtin_amdgcn_sched_barrier(0); const int row = row0 + ai * 128 + m * 16; const float4 pr = *(const float4*)(prow + (size_t)row * 16 + u.b * 4);
                const float inv = 1.f / ((pr.x + pr.y) + (pr.z + pr.w)); bf16_t* rowp = O + (size_t)row * 2048 + col0;
#pragma unroll
                for (int bj = 0; bj < 2; ++bj)
#pragma unroll
                    for (int n = 0; n < 2; ++n) { f32x4 v = acc[ai][bj][m][n] * inv; uint2 o; o.x = pack2(v[0], v[1]); o.y = pack2(v[2], v[3]); *(uint2*)(rowp + bj * 128 + n * 16) = o; } }
    }
};

template <class Epi>
__device__ __forceinline__ void run_gemm(LAS unsigned char* lds, const bf16_t* A, const bf16_t* Bt, int lda, int ldb, int K, int nM, int nN, int nB, size_t sA, size_t sB, const Epi& E, int cshift) {
    Gemm g; g.A = A; g.Bt = Bt; g.lda = lda; g.ldb = ldb; g.K = K; g.nM = nM; g.nN = nN; g.nB = nB; g.sA = sA; g.sB = sB;
    pg8::Order S; S.init(g, (int)gridDim.x, (int)((blockIdx.x + cshift) % gridDim.x));
    pg8::gemm_phase<Epi>(lds, g, S, E);
}

__device__ void convT(const float* __restrict__ src, bf16_t* __restrict__ dst, const float* __restrict__ gain, int K, int N, int Npad, float* tile) {
    const int tidx = ltid();
    const int tn = Npad / 64, ntile = (K / 64) * tn;
    for (int t = blockIdx.x; t < ntile; t += gridDim.x) {
        const int k0 = (t / tn) * 64, n0 = (t % tn) * 64;
        const int nn = tidx & 63, kb = tidx >> 6;
#pragma unroll
        for (int i = 0; i < 8; ++i) { const int kk = kb + 8 * i, n = n0 + nn; float v = (n < N) ? src[(size_t)(k0 + kk) * N + n] : 0.f; if (gain) v *= gain[k0 + kk]; tile[kk * 65 + nn] = v; }
        __syncthreads();
        const int kp = (tidx & 31) * 2, nb2 = tidx >> 5;
#pragma unroll
        for (int i = 0; i < 4; ++i) { const int n2 = nb2 + 16 * i; *(unsigned*)(dst + (size_t)(n0 + n2) * K + k0 + kp) = pack2(tile[kp * 65 + n2], tile[(kp + 1) * 65 + n2]); }
        __syncthreads();
    }
}
__device__ void rows_to_bf16(const float* __restrict__ x, bf16_t* __restrict__ xb, float* __restrict__ rstd, const float* __restrict__ gain, int rows) {
    const int tidx = ltid();
    const int gw = blockIdx.x * 8 + (tidx >> 6), nw = gridDim.x * 8, lane = tidx & 63;
    for (int r = gw; r < rows; r += nw) {
        const float4* p = (const float4*)(x + (size_t)r * 2048);
        float4 v[8]; float ss = 0.f;
#pragma unroll
        for (int i = 0; i < 8; ++i) { v[i] = p[i * 64 + lane]; ss += v[i].x * v[i].x + v[i].y * v[i].y + v[i].z * v[i].z + v[i].w * v[i].w; }
        ss = wsum(ss); const float rs = rsqrtf(ss * (1.f / 2048.f) + 1e-6f);
        if (rstd && lane == 0) rstd[r] = rs;
#pragma unroll
        for (int i = 0; i < 8; ++i) { float4 w = v[i];
            if (gain) { const float4 gg = ((const float4*)gain)[i * 64 + lane]; w.x *= rs * gg.x; w.y *= rs * gg.y; w.z *= rs * gg.z; w.w *= rs * gg.w; }
            uint2 o; o.x = pack2(w.x, w.y); o.y = pack2(w.z, w.w); *(uint2*)(xb + (size_t)r * 2048 + (size_t)(i * 64 + lane) * 4) = o; }
    }
}

__device__ __forceinline__ float yget(const float* yseg, const float* carry_prev, int seg, int tl, int col) {
    if (tl >= 0) return yseg[(size_t)tl * NINP + col];
    if (seg == 0) return 0.f;
    return carry_prev[(size_t)(3 + tl) * NINP + col];
}
__device__ void rwkv_prep_tile(const Params& p, int seg, int tile, int cc, float* act  ) {
    const int tidx = ltid();
    const float* yseg = (const float*)(p.ws + OFF_YSEG);
    const float* carry_prev = (const float*)(p.ws + OFF_CARRY) + (size_t)((seg + 1) & 1) * 3 * NINP;
    const float* mu = p.in[8]; const float* w0 = p.in[9]; const float* w2 = p.in[10]; const float* a0 = p.in[11]; const float* a2 = p.in[12]; const float* g2 = p.in[13];
    const float* k_k = p.in[14]; const float* k_a = p.in[15]; const float* r_k = p.in[16];
    float* rrec = (float*)(p.ws + OFF_RREC); float* bonus = (float*)(p.ws + OFF_BONUS); float* gate = (float*)(p.ws + OFF_GATE);
    const int tid = tidx, tl0 = tile * 16;
    __syncthreads();
    for (int idx = tid; idx < 16 * 288; idx += 512) {
        const int tok = idx / 288, i = idx % 288, col = RW0 + 3072 + i, tl = tl0 + tok;
        const float cur = yseg[(size_t)tl * NINP + col], prev = yget(yseg, carry_prev, seg, tl - 1, col);
        const float yl = cur + (prev - cur) * mu[3072 + i];
        act[i * 16 + tok] = i < 64 ? tanhf(yl) : (i < 128 ? yl : sigmoidf_(yl));
    }
    __syncthreads();
    {
        const int c = tid + cc * 512, h = c >> 6, j = c & 63;
        float aw[16], aa[16], ag[16];
#pragma unroll
        for (int q = 0; q < 16; ++q) { aw[q] = 0.f; aa[q] = 0.f; ag[q] = 0.f; }
#pragma unroll 2
        for (int i = 0; i < 64; ++i) { const float w = w2[i * 1024 + c]; const float4* ap = (const float4*)(act + i * 16);
#pragma unroll
            for (int q4 = 0; q4 < 4; ++q4) { const float4 a = ap[q4]; aw[q4 * 4 + 0] += a.x * w; aw[q4 * 4 + 1] += a.y * w; aw[q4 * 4 + 2] += a.z * w; aw[q4 * 4 + 3] += a.w * w; } }
#pragma unroll 2
        for (int i = 0; i < 64; ++i) { const float w = a2[i * 1024 + c]; const float4* ap = (const float4*)(act + (64 + i) * 16);
#pragma unroll
            for (int q4 = 0; q4 < 4; ++q4) { const float4 a = ap[q4]; aa[q4 * 4 + 0] += a.x * w; aa[q4 * 4 + 1] += a.y * w; aa[q4 * 4 + 2] += a.z * w; aa[q4 * 4 + 3] += a.w * w; } }
#pragma unroll 2
        for (int i = 0; i < 160; ++i) { const float w = g2[i * 1024 + c]; const float4* ap = (const float4*)(act + (128 + i) * 16);
#pragma unroll
            for (int q4 = 0; q4 < 4; ++q4) { const float4 a = ap[q4]; ag[q4 * 4 + 0] += a.x * w; ag[q4 * 4 + 1] += a.y * w; ag[q4 * 4 + 2] += a.z * w; ag[q4 * 4 + 3] += a.w * w; } }
        const float w0c = w0[c], a0c = a0[c], kkc = k_k[c], kac = k_a[c], rkc = r_k[c], mur = mu[c], muk = mu[1024 + c], muv = mu[2048 + c];
#pragma unroll
        for (int q = 0; q < 16; ++q) {
            const int tl = tl0 + q;
            const float rc = yseg[(size_t)tl * NINP + RW0 + c], kc = yseg[(size_t)tl * NINP + RW0 + 1024 + c], vc = yseg[(size_t)tl * NINP + RW0 + 2048 + c];
            const float rp = yget(yseg, carry_prev, seg, tl - 1, RW0 + c), kp = yget(yseg, carry_prev, seg, tl - 1, RW0 + 1024 + c), vp = yget(yseg, carry_prev, seg, tl - 1, RW0 + 2048 + c);
            const float r = rc + (rp - rc) * mur, k = kc + (kp - kc) * muk, v = vc + (vp - vc) * muv;
            const float wlog = -softplusf_(-(w0c + aw[q])) - 0.5f;
            const float decay = __expf(-__expf(wlog));
            const float a = sigmoidf_(a0c + aa[q]);
            const float kx = k * kkc; const float n2 = wsum(kx * kx); const float kk = kx * rsqrtf(n2 + 1e-6f);
            const float k2 = k * (1.f + (a - 1.f) * kac);
            const float bsum = wsum(r * k2 * rkc);
            float* rec = rrec + ((size_t)tl * 16 + h) * RREC + j;
            rec[0] = decay; rec[64] = -kk; rec[128] = kk * a; rec[192] = k2; rec[256] = r; rec[320] = v;
            bonus[(size_t)tl * 1024 + c] = bsum * v; gate[(size_t)tl * 1024 + c] = ag[q];
        }
    }
}
__device__ __forceinline__ f32x4 mfma16(bf16x8 a, bf16x8 b, f32x4 c) { return __builtin_amdgcn_mfma_f32_16x16x32_bf16(a, b, c, 0, 0, 0); }
__device__ void gdn_prep_chunk(const Params& p, int seg, int task, unsigned char* shm) {
    const int tidx = ltid();
    const int h = task & 7, cn = task >> 3, tl0 = cn * 64, wave = tidx >> 6, l = tidx & 63;
    float* qf = (float*)(shm + GP_QF); float* kf = (float*)(shm + GP_KF); float* vf = (float*)(shm + GP_VF);
    float* Mm = (float*)(shm + GP_MM); float* Am = (float*)(shm + GP_AM); bf16_t* ktT = (bf16_t*)(shm + GP_KTT); bf16_t* Ab = (bf16_t*)(shm + GP_AB);
    float* sm = (float*)(shm + GP_SM);
    const float* yseg = (const float*)(p.ws + OFF_YSEG);
    const float* carry_prev = (const float*)(p.ws + OFF_CARRY) + (size_t)((seg + 1) & 1) * 3 * NINP;
    const float* cw = p.in[4]; const float* A_log = p.in[5]; const float* dtb = p.in[6];
    float* sz = (float*)(p.ws + OFF_SZ);
    __syncthreads();
#ifndef NO_S1
    {
        float wq[4][2], wk[4][2], wv[4][2];
#pragma unroll
        for (int j = 0; j < 4; ++j)
#pragma unroll
            for (int e = 0; e < 2; ++e) { const int col = h * 128 + 2 * l + e; wq[j][e] = cw[j * 3072 + col]; wk[j][e] = cw[j * 3072 + 1024 + col]; wv[j][e] = cw[j * 3072 + 2048 + col]; }
        const float nA = -__expf(A_log[h]), db = dtb[h];
#pragma unroll 1
        for (int q8 = 0; q8 < 8; ++q8) {
            const int tok = wave * 8 + q8, tl = tl0 + tok;
            float qv[2] = {0.f, 0.f}, kv[2] = {0.f, 0.f}, vv[2] = {0.f, 0.f};
#pragma unroll
            for (int j = 0; j < 4; ++j)
#pragma unroll
                for (int e = 0; e < 2; ++e) { const int col = h * 128 + 2 * l + e; const int ts = tl - 3 + j;
                    qv[e] += wq[j][e] * yget(yseg, carry_prev, seg, ts, col); kv[e] += wk[j][e] * yget(yseg, carry_prev, seg, ts, 1024 + col); vv[e] += wv[j][e] * yget(yseg, carry_prev, seg, ts, 2048 + col); }
#pragma unroll
            for (int e = 0; e < 2; ++e) { qv[e] = siluf_(qv[e]); kv[e] = siluf_(kv[e]); vv[e] = siluf_(vv[e]); }
            const float qn = wsum(qv[0] * qv[0] + qv[1] * qv[1]), kn = wsum(kv[0] * kv[0] + kv[1] * kv[1]);
            const float qs = rsqrtf(qn + 1e-6f) * 0.08838834764831845f, ks = rsqrtf(kn + 1e-6f);
            *(float2*)(qf + tok * 132 + 2 * l) = make_float2(qv[0] * qs, qv[1] * qs);
            *(float2*)(kf + tok * 132 + 2 * l) = make_float2(kv[0] * ks, kv[1] * ks);
            *(float2*)(vf + tok * 132 + 2 * l) = make_float2(vv[0], vv[1]);
            if (l == 0) { const float adt = yseg[(size_t)tl * NINP + 4096 + h], bb = yseg[(size_t)tl * NINP + 4104 + h];
                sm[tok] = nA * softplusf_(adt + db); sm[64 + tok] = sigmoidf_(bb); }
            const float2 z = *(const float2*)(yseg + (size_t)tl * NINP + 3072 + h * 128 + 2 * l);
            *(float2*)(sz + (size_t)tl * 1024 + h * 128 + 2 * l) = make_float2(siluf_(z.x), siluf_(z.y));
        }
    }
#endif
    __syncthreads();
    if (wave == 0) {
        float g = sm[l];
#pragma unroll
        for (int o = 1; o < 64; o <<= 1) { const float t = __shfl_up(g, o); if (l >= o) g += t; }
        const float Gl = __shfl(g, 63);
        sm[l] = g; sm[128 + l] = __expf(g); sm[192 + l] = __expf(Gl - g);
        if (l == 63) ((float*)(p.ws + OFF_EG))[task] = __expf(g);
    }
    __syncthreads();
#ifndef NO_S2
    {
        const int t2 = ltid(); const int i0 = (t2 >> 4) * 2, j0 = (t2 & 15) * 4;
        float kk[2][4], qk[2][4];
#pragma unroll
        for (int a = 0; a < 2; ++a)
#pragma unroll
            for (int b = 0; b < 4; ++b) { kk[a][b] = 0.f; qk[a][b] = 0.f; }
#pragma unroll 2
        for (int d = 0; d < 128; d += 4) {
            const float4 ki0 = *(const float4*)(kf + i0 * 132 + d), ki1 = *(const float4*)(kf + (i0 + 1) * 132 + d);
            const float4 qi0 = *(const float4*)(qf + i0 * 132 + d), qi1 = *(const float4*)(qf + (i0 + 1) * 132 + d);
#pragma unroll
            for (int b = 0; b < 4; ++b) { const float4 kj = *(const float4*)(kf + (j0 + b) * 132 + d);
                kk[0][b] += ki0.x * kj.x + ki0.y * kj.y + ki0.z * kj.z + ki0.w * kj.w; kk[1][b] += ki1.x * kj.x + ki1.y * kj.y + ki1.z * kj.z + ki1.w * kj.w;
                qk[0][b] += qi0.x * kj.x + qi0.y * kj.y + qi0.z * kj.z + qi0.w * kj.w; qk[1][b] += qi1.x * kj.x + qi1.y * kj.y + qi1.z * kj.z + qi1.w * kj.w; }
        }
#pragma unroll
        for (int a = 0; a < 2; ++a)
#pragma unroll
            for (int b = 0; b < 4; ++b) { const int i = i0 + a, j = j0 + b; const float gam = (i >= j) ? __expf(sm[i] - sm[j]) : 0.f;
                Mm[i * 64 + j] = (i > j) ? sm[64 + i] * kk[a][b] * gam : 0.f; Am[i * 64 + j] = qk[a][b] * gam; }
    }
#endif
    __syncthreads();
    float* UWg = (float*)(p.ws + OFF_UW) + (size_t)task * 16384;
    if (tidx < 256) {
        float X[64];
        const int c = ltid();
        {
            const float* srcp = (c < 128) ? (vf + c) : (kf + (c - 128));
#pragma unroll
            for (int i = 0; i < 64; ++i) { float sc = sm[64 + i]; if (c >= 128) sc *= sm[128 + i]; X[i] = srcp[i * 132] * sc; }
        }
#pragma unroll
        for (int i = 1; i < 64; ++i) {
            float a0 = 0.f, a1 = 0.f;
#pragma unroll
            for (int jj = 0; jj < (i + 3) / 4; ++jj) { const float4 m = *(const float4*)(Mm + i * 64 + 4 * jj);
                a0 += m.x * X[4 * jj] + m.z * X[4 * jj + 2]; a1 += m.y * X[4 * jj + 1] + m.w * X[4 * jj + 3]; }
            X[i] -= a0 + a1;
        }
#pragma unroll
        for (int i = 0; i < 64; ++i) UWg[i * 256 + c] = X[i];
    }
    __syncthreads();
    {
        const int t5 = ltid(); const int d = t5 & 127, iq = t5 >> 7;
#pragma unroll 4
        for (int ii = 0; ii < 16; ii += 2) { const int i = iq * 16 + ii;
            *(unsigned*)(ktT + d * 72 + i) = pack2(kf[i * 132 + d] * sm[192 + i], kf[(i + 1) * 132 + d] * sm[192 + i + 1]); }
#pragma unroll 4
        for (int e = 0; e < 4; ++e) { const int idx = (e * 512 + t5) * 2, i = idx >> 6, j = idx & 63;
            *(unsigned*)(Ab + i * 72 + j) = pack2(Am[i * 64 + j], Am[i * 64 + j + 1]); }
#pragma unroll 4
        for (int e = 0; e < 16; ++e) { const int idx = e * 512 + t5, i = idx >> 7, dd = idx & 127; qf[i * 132 + dd] *= sm[128 + i]; }
    }
    __syncthreads();
#ifndef NO_S4
    {
        const int t4 = ltid(); const int r = t4 & 15, qd = (t4 & 63) >> 4, m0 = (t4 >> 6) * 16;
        bf16x8 aW[2], aU[2];
#pragma unroll
        for (int ks = 0; ks < 2; ++ks)
#pragma unroll
            for (int e = 0; e < 8; ++e) { const float* rp = UWg + (ks * 32 + qd * 8 + e) * 256 + m0 + r; aU[ks][e] = (short)f2bf(rp[0]); aW[ks][e] = (short)f2bf(rp[128]); }
        bf16_t* PMg = (bf16_t*)(p.ws + OFF_PM) + (size_t)task * 16384; float* RNg = (float*)(p.ws + OFF_RN) + (size_t)task * 16384;
        bf16_t* QPg = (bf16_t*)(p.ws + OFF_QP) + (size_t)task * 8192; float* OLg = (float*)(p.ws + OFF_OL) + (size_t)task * 8192;
#pragma unroll 2
        for (int n = 0; n < 8; ++n) {
            const bf16x8 b0 = *(const bf16x8*)(ktT + (16 * n + r) * 72 + qd * 8), b1 = *(const bf16x8*)(ktT + (16 * n + r) * 72 + 32 + qd * 8);
            f32x4 cp = (f32x4){0.f, 0.f, 0.f, 0.f}, cr = (f32x4){0.f, 0.f, 0.f, 0.f};
            cp = mfma16(aW[0], b0, cp); cp = mfma16(aW[1], b1, cp); cr = mfma16(aU[0], b0, cr); cr = mfma16(aU[1], b1, cr);
            const int d = 16 * n + r, c = m0 + qd * 4;
            uint2 o; o.x = pack2(-cp[0], -cp[1]); o.y = pack2(-cp[2], -cp[3]); *(uint2*)(PMg + d * 128 + c) = o;
            *(f32x4*)(RNg + d * 128 + c) = cr;
        }
#pragma unroll 2
        for (int n = 0; n < 4; ++n) {
            const bf16x8 b0 = *(const bf16x8*)(Ab + (16 * n + r) * 72 + qd * 8), b1 = *(const bf16x8*)(Ab + (16 * n + r) * 72 + 32 + qd * 8);
            f32x4 cq = (f32x4){0.f, 0.f, 0.f, 0.f}, co = (f32x4){0.f, 0.f, 0.f, 0.f};
            cq = mfma16(aW[0], b0, cq); cq = mfma16(aW[1], b1, cq); co = mfma16(aU[0], b0, co); co = mfma16(aU[1], b1, co);
            const int i = 16 * n + r, dm = m0 + qd * 4;
            const float4 qv = *(const float4*)(qf + i * 132 + dm);
            uint2 o; o.x = pack2(qv.x - cq[0], qv.y - cq[1]); o.y = pack2(qv.z - cq[2], qv.w - cq[3]); *(uint2*)(QPg + i * 128 + dm) = o;
            *(f32x4*)(OLg + i * 128 + dm) = co;
        }
    }
#endif
}

__device__ void rwkv_scan(const Params& p, int seg, int hb, float* lds) {
    const int tidx = ltid();
    const float* rrec = (const float*)(p.ws + OFF_RREC); float* orw = (float*)(p.ws + OFF_ORW); float* SR = (float*)(p.ws + OFF_SR);
    const int tid = tidx, wave = tid >> 6, lane = tid & 63, head = hb >> 2, rq = hb & 3;
    const int row = rq * 16 + (wave & 3) * 4 + (lane >> 4), j = lane & 15;
    constexpr int TS = 32, TF = TS * RREC;
    float4 S = make_float4(0.f, 0.f, 0.f, 0.f);
    if (wave < 4 && seg > 0) S = *(const float4*)(SR + ((size_t)head * 64 + row) * 64 + 4 * j);
    float4 rg0, rg1, rg2, rg3, rg4, rg5;
#define RW_GL(R, i, tile_) { const int e = tid + (i) * 512, st = e / 96, off = e % 96; R = *(const float4*)(rrec + ((size_t)((tile_) * TS + st) * 16 + head) * RREC + off * 4); }
#define RW_GLOAD(tile_) { RW_GL(rg0, 0, tile_) RW_GL(rg1, 1, tile_) RW_GL(rg2, 2, tile_) RW_GL(rg3, 3, tile_) RW_GL(rg4, 4, tile_) RW_GL(rg5, 5, tile_) }
#define RW_LS(R, i, buf_) { *(float4*)(lds + (buf_) * TF + (tid + (i) * 512) * 4) = R; }
#define RW_LSTORE(buf_) { RW_LS(rg0, 0, buf_) RW_LS(rg1, 1, buf_) RW_LS(rg2, 2, buf_) RW_LS(rg3, 3, buf_) RW_LS(rg4, 4, buf_) RW_LS(rg5, 5, buf_) }
    __syncthreads();
    RW_GLOAD(0); RW_LSTORE(0); __syncthreads();
    int cur = 0;
    for (int tile = 0; tile < SEG / TS; ++tile) {
        const int ntile = (tile + 1 < SEG / TS) ? tile + 1 : tile;
        RW_GLOAD(ntile);
        if (wave < 4) {
            const float* base = lds + cur * TF;
#pragma unroll 4
            for (int st = 0; st < TS; ++st, base += RREC) {
                const float4 w4 = *(const float4*)(base + 4 * j), a4 = *(const float4*)(base + 64 + 4 * j), b4 = *(const float4*)(base + 128 + 4 * j);
                const float4 k4 = *(const float4*)(base + 192 + 4 * j), r4 = *(const float4*)(base + 256 + 4 * j); const float vv = base[320 + row];
                float sa = (S.x * a4.x + S.y * a4.y) + (S.z * a4.z + S.w * a4.w);
                sa = allred16(sa);
                S.x = S.x * w4.x + (sa * b4.x + vv * k4.x); S.y = S.y * w4.y + (sa * b4.y + vv * k4.y);
                S.z = S.z * w4.z + (sa * b4.z + vv * k4.z); S.w = S.w * w4.w + (sa * b4.w + vv * k4.w);
                float o = (S.x * r4.x + S.y * r4.y) + (S.z * r4.z + S.w * r4.w);
                o = allred16(o);
                if (j == 0) orw[(size_t)(tile * TS + st) * 1024 + head * 64 + row] = o;
            }
        }
        RW_LSTORE(cur ^ 1);
        __syncthreads();
        cur ^= 1;
    }
#undef RW_GL
#undef RW_GLOAD
#undef RW_LS
#undef RW_LSTORE
    if (wave < 4) *(float4*)(SR + ((size_t)head * 64 + row) * 64 + 4 * j) = S;
}
__device__ void gdn_scan(const Params& p, int seg, int gb, unsigned char* shm) {
    const int tidx = ltid(), wave = tidx >> 6, l = tidx & 63, r = l & 15, qd = l >> 4;
    const int head = gb >> 2, c0 = (gb & 3) * 32, m0 = wave * 16;
    bf16_t* ST = (bf16_t*)shm;
    float* SG = (float*)(p.ws + OFF_SG);
    const bf16_t* PM = (const bf16_t*)(p.ws + OFF_PM); const float* RN = (const float*)(p.ws + OFF_RN); const float* EG = (const float*)(p.ws + OFF_EG);
    bf16_t* SH = (bf16_t*)(p.ws + OFF_SH);
    f32x4 acc[2];
#pragma unroll
    for (int n = 0; n < 2; ++n)
#pragma unroll
        for (int j = 0; j < 4; ++j) acc[n][j] = seg > 0 ? SG[((size_t)head * 128 + m0 + qd * 4 + j) * 128 + c0 + 16 * n + r] : 0.f;
#define GS_PUT(buf_, task_, wr_hist_) { _Pragma("unroll") for (int n = 0; n < 2; ++n) { uint2 o; o.x = pack2(acc[n][0], acc[n][1]); o.y = pack2(acc[n][2], acc[n][3]); \
        *(uint2*)(ST + ((buf_) * 32 + 16 * n + r) * 136 + m0 + qd * 4) = o; \
        if (wr_hist_) *(uint2*)(SH + (size_t)(task_) * 16384 + (c0 + 16 * n + r) * 128 + m0 + qd * 4) = o; } }
    __syncthreads();
    GS_PUT(0, head, true);
    __syncthreads();
    bf16x8 aP[4]; float Rr[2][4]; float eg;
    { const int task = head;
#pragma unroll
      for (int ks = 0; ks < 4; ++ks) aP[ks] = *(const bf16x8*)(PM + (size_t)task * 16384 + (m0 + r) * 128 + ks * 32 + qd * 8);
#pragma unroll
      for (int n = 0; n < 2; ++n)
#pragma unroll
          for (int j = 0; j < 4; ++j) Rr[n][j] = RN[(size_t)task * 16384 + (m0 + qd * 4 + j) * 128 + c0 + 16 * n + r];
      eg = EG[task]; }
    int cur = 0;
#pragma unroll 1
    for (int cn = 0; cn < SEG / 64; ++cn) {
        const int cnn = (cn + 1 < SEG / 64) ? cn + 1 : cn, ntask = cnn * 8 + head;
        bf16x8 nP[4]; float nR[2][4];
#pragma unroll
        for (int ks = 0; ks < 4; ++ks) nP[ks] = *(const bf16x8*)(PM + (size_t)ntask * 16384 + (m0 + r) * 128 + ks * 32 + qd * 8);
#pragma unroll
        for (int n = 0; n < 2; ++n)
#pragma unroll
            for (int j = 0; j < 4; ++j) nR[n][j] = RN[(size_t)ntask * 16384 + (m0 + qd * 4 + j) * 128 + c0 + 16 * n + r];
        const float neg = EG[ntask];
#pragma unroll
        for (int n = 0; n < 2; ++n) {
#pragma unroll
            for (int j = 0; j < 4; ++j) acc[n][j] = acc[n][j] * eg + Rr[n][j];
#pragma unroll
            for (int ks = 0; ks < 4; ++ks) { const bf16x8 b = *(const bf16x8*)(ST + (cur * 32 + 16 * n + r) * 136 + ks * 32 + qd * 8); acc[n] = mfma16(aP[ks], b, acc[n]); }
        }
        GS_PUT(cur ^ 1, ntask, (cn + 1 < SEG / 64));
        __syncthreads();
        cur ^= 1;
#pragma unroll
        for (int ks = 0; ks < 4; ++ks) aP[ks] = nP[ks];
#pragma unroll
        for (int n = 0; n < 2; ++n)
#pragma unroll
            for (int j = 0; j < 4; ++j) Rr[n][j] = nR[n][j];
        eg = neg;
    }
#undef GS_PUT
#pragma unroll
    for (int n = 0; n < 2; ++n)
#pragma unroll
        for (int j = 0; j < 4; ++j) SG[((size_t)head * 128 + m0 + qd * 4 + j) * 128 + c0 + 16 * n + r] = acc[n][j];
}
__device__ void gdn_out(const Params& p, int seg) {
    const int tidx = ltid(), wave = tidx >> 6, l = tidx & 63, r = l & 15, qd = l >> 4, i0 = (wave & 3) * 16;
    const bf16_t* QP = (const bf16_t*)(p.ws + OFF_QP); const float* OL = (const float*)(p.ws + OFF_OL); const bf16_t* SH = (const bf16_t*)(p.ws + OFF_SH);
    const float* sz = (const float*)(p.ws + OFF_SZ); const float* gnw = p.in[7];
    bf16_t* mixed = (bf16_t*)(p.ws + OFF_AB1);
    for (int tp = blockIdx.x; tp < NTASK / 2; tp += gridDim.x) {
        const int task = tp * 2 + (wave >> 2), h = task & 7, cn = task >> 3;
        bf16x8 aQ[4];
#pragma unroll
        for (int ks = 0; ks < 4; ++ks) aQ[ks] = *(const bf16x8*)(QP + (size_t)task * 8192 + (i0 + r) * 128 + ks * 32 + qd * 8);
        f32x4 acc[8];
#pragma unroll
        for (int n = 0; n < 8; ++n)
#pragma unroll
            for (int j = 0; j < 4; ++j) acc[n][j] = OL[(size_t)task * 8192 + (i0 + qd * 4 + j) * 128 + 16 * n + r];
#pragma unroll
        for (int n = 0; n < 8; ++n)
#pragma unroll
            for (int ks = 0; ks < 4; ++ks) { const bf16x8 b = *(const bf16x8*)(SH + (size_t)task * 16384 + (16 * n + r) * 128 + ks * 32 + qd * 8); acc[n] = mfma16(aQ[ks], b, acc[n]); }
#pragma unroll
        for (int j = 0; j < 4; ++j) {
            float ss = 0.f;
#pragma unroll
            for (int n = 0; n < 8; ++n) ss += acc[n][j] * acc[n][j];
            ss = allred16(ss);
            const float rs = rsqrtf(ss * (1.f / 128.f) + 1e-6f);
            const int tl = cn * 64 + i0 + qd * 4 + j;
#pragma unroll
            for (int n = 0; n < 8; ++n) { const int c = 16 * n + r;
                mixed[(size_t)(seg * SEG + tl) * 2048 + h * 128 + c] = f2bf(acc[n][j] * rs * gnw[c] * sz[(size_t)tl * 1024 + h * 128 + c]); }
        }
    }
}

__device__ void mixer_post(const Params& p, int seg) {
    const int tidx = ltid();
    const float* orw = (const float*)(p.ws + OFF_ORW);
    const float* sz = (const float*)(p.ws + OFF_SZ); const float* bonus = (const float*)(p.ws + OFF_BONUS); const float* gate = (const float*)(p.ws + OFF_GATE);
    const float* lnw = p.in[17]; const float* lnb = p.in[18];
    bf16_t* mixed = (bf16_t*)(p.ws + OFF_AB1);
    const int gw = blockIdx.x * 8 + (tidx >> 6), nw = gridDim.x * 8, l = tidx & 63;
    for (int tl = gw; tl < SEG; tl += nw) {
        bf16_t* mrow = mixed + (size_t)(seg * SEG + tl) * 2048;
#pragma unroll 2
        for (int h = 0; h < 16; ++h) {
            const int c = h * 64 + l;
            const float o = orw[(size_t)tl * 1024 + c];
            const float mean = wsum(o) * (1.f / 64.f); const float d = o - mean; const float var = wsum(d * d) * (1.f / 64.f);
            const float y = d * rsqrtf(var + 64e-5f) * lnw[c] + lnb[c];
            mrow[1024 + c] = f2bf((y + bonus[(size_t)tl * 1024 + c]) * gate[(size_t)tl * 1024 + c]);
        }
    }
}

#ifndef GM
#define GM 0xFFFFFFFFu
#endif
constexpr unsigned PH_ALL = 0x1FFFu;
template <unsigned PH> __global__ void __launch_bounds__(512, 2) mega(Params p, int seg_lo, int seg_hi) {
    extern __shared__ __attribute__((aligned(16))) unsigned char shm[];
#define SYNC() do { if constexpr (PH == PH_ALL) cg::this_grid().sync(); } while (0)
    LAS unsigned char* lds = (LAS unsigned char*)shm;
    float* ldsf = (float*)shm;
#define WSB (p.ws)
#define WIN ((bf16_t*)(WSB + OFF_WIN))
#define WOUT ((bf16_t*)(WSB + OFF_WOUT))
#define WQ ((bf16_t*)(WSB + OFF_WQ))
#define WK ((bf16_t*)(WSB + OFF_WK))
#define WV ((bf16_t*)(WSB + OFF_WV))
#define WO ((bf16_t*)(WSB + OFF_WO))
#define WUP ((bf16_t*)(WSB + OFF_WUP))
#define WDN ((bf16_t*)(WSB + OFF_WDN))
#define MN ((bf16_t*)(WSB + OFF_MN))
#define KX ((bf16_t*)(WSB + OFF_KX))
#define VT ((bf16_t*)(WSB + OFF_VT))
#define RSTDX ((float*)(WSB + OFF_RSTDX))
#define SSQ1 ((float*)(WSB + OFF_SSQ1))
#define SSQ2 ((float*)(WSB + OFF_SSQ2))
#define PROW ((float*)(WSB + OFF_PROW))
#define AB0 ((bf16_t*)(WSB + OFF_AB0))
#define AB1 ((bf16_t*)(WSB + OFF_AB1))
#define UB ((bf16_t*)(WSB + OFF_U))
#define YSEG ((float*)(WSB + OFF_YSEG))

    if constexpr (PH & 1u) {
    convT(p.in[3], WIN, p.in[2], D, NIN, NINP, ldsf);
    convT(p.in[19], WOUT, nullptr, D, D, D, ldsf);
    convT(p.in[22], WQ, p.in[20], D, D, D, ldsf);
    convT(p.in[23], WK, nullptr, D, D, D, ldsf);
    convT(p.in[24], WV, nullptr, D, D, D, ldsf);
    convT(p.in[25], WO, nullptr, D, D, D, ldsf);
    convT(p.in[27], WUP, p.in[26], D, DFF, DFF, ldsf);
    convT(p.in[28], WDN, nullptr, DFF, D, D, ldsf);
    rows_to_bf16(p.in[0], AB0, RSTDX, nullptr, T);
    rows_to_bf16(p.in[1], MN, nullptr, p.in[21], 256);
    }
    SYNC();

    if constexpr (PH & 0xEu)
    for (int seg = seg_lo; seg < seg_hi; ++seg) {
        if constexpr (PH & 2u) {
        if (seg > 0) { gdn_out(p, seg - 1); mixer_post(p, seg - 1); }
        { EpiY e; e.Y = YSEG; e.ldc = NINP; e.rstd = RSTDX + seg * SEG;
          if (GM & (1u << 0)) run_gemm(lds, AB0 + (size_t)seg * SEG * D, WIN, D, D, D, SEG / 256, NINP / 256, 1, 0, 0, e, 0); }
        if (seg == 0) {
            { EpiBf e; e.O = KX; e.ldc = D; e.ssq = nullptr; if (GM & (1u << 1)) run_gemm(lds, MN, WK, D, D, D, 1, 8, 1, 0, 0, e, 16); }
            { EpiBf e; e.O = VT; e.ldc = 256; e.ssq = nullptr; if (GM & (1u << 2)) run_gemm(lds, WV, MN, D, D, D, 8, 1, 1, 0, 0, e, 8); }
        }
        }
        SYNC();
        if constexpr (PH & 4u) {
#ifndef SKIP_RP
        rwkv_prep_tile(p, seg, blockIdx.x >> 1, blockIdx.x & 1, ldsf);
#endif
#ifndef SKIP_GP
        gdn_prep_chunk(p, seg, blockIdx.x, shm);
#endif
        if (blockIdx.x == 255) {
            float* carry = (float*)(WSB + OFF_CARRY) + (size_t)(seg & 1) * 3 * NINP;
            for (int i = ltid(); i < 3 * NINP; i += 512) carry[i] = YSEG[(size_t)(SEG - 3) * NINP + i];
        }
        }
        SYNC();
        if constexpr (PH & 8u) {
#ifndef SKIP_GS
        if (blockIdx.x < 32) gdn_scan(p, seg, blockIdx.x, shm);
#endif
#ifndef SKIP_RS
        if (blockIdx.x >= 32 && blockIdx.x < 96) rwkv_scan(p, seg, blockIdx.x - 32, ldsf);
#endif
        }
        SYNC();
    }
    if constexpr (PH & 16u) { gdn_out(p, NSEG - 1); mixer_post(p, NSEG - 1); }
    SYNC();
    if constexpr (PH & 32u) { EpiRes e; e.R = p.in[0]; e.H = p.out; e.HB = AB0; e.ssq = SSQ1; if (GM & (1u << 3)) run_gemm(lds, AB1, WOUT, D, D, D, T / 256, 8, 1, 0, 0, e, 0); }
    SYNC();
    if constexpr (PH & 64u) { EpiBf e; e.O = AB1; e.ldc = D; e.ssq = SSQ1; if (GM & (1u << 4)) run_gemm(lds, AB0, WQ, D, D, D, T / 256, 8, 1, 0, 0, e, 0); }
    SYNC();
    if constexpr (PH & 128u) { EpiScore e; e.P = AB0; e.prow = PROW; e.scale = 0.044194173824159216f; if (GM & (1u << 5)) run_gemm(lds, AB1, KX, D, D, 512, T / 256, 1, 4, 512, 512, e, 0); }
    SYNC();
    if constexpr (PH & 256u) { EpiPV e; e.O = AB1; e.prow = PROW; if (GM & (1u << 6)) run_gemm(lds, AB0, VT, 1024, 256, 256, T / 256, 2, 4, 256, (size_t)512 * 256, e, 0); }
    SYNC();
    if constexpr (PH & 512u) { EpiRes e; e.R = p.out; e.H = p.out; e.HB = AB0; e.ssq = SSQ2; if (GM & (1u << 7)) run_gemm(lds, AB1, WO, D, D, D, T / 256, 8, 1, 0, 0, e, 0); }
    SYNC();
    if constexpr (PH & 1024u) { EpiUp e; e.O = UB; e.ldc = DFF; e.ssq = SSQ2; if (GM & (1u << 8)) run_gemm(lds, AB0, WUP, D, D, D, T / 256, DFF / 256, 1, 0, 0, e, 0); }
    SYNC();
    if constexpr (PH & 2048u) { EpiRes e; e.R = p.out; e.H = p.out; e.HB = nullptr; e.ssq = nullptr; if (GM & (1u << 9)) run_gemm(lds, UB, WDN, DFF, DFF, DFF, T / 256, 8, 1, 0, 0, e, 0); }
    SYNC();
    if constexpr (PH & 4096u) {
        const float* gain = p.in[29];
        const int tidx = ltid(); const int gw = blockIdx.x * 8 + (tidx >> 6), nw = gridDim.x * 8, lane = tidx & 63;
        for (int r = gw; r < T; r += nw) {
            float4* pr = (float4*)(p.out + (size_t)r * 2048);
            float4 v[8]; float ss = 0.f;
#pragma unroll
            for (int i = 0; i < 8; ++i) { v[i] = pr[i * 64 + lane]; ss += v[i].x * v[i].x + v[i].y * v[i].y + v[i].z * v[i].z + v[i].w * v[i].w; }
            ss = wsum(ss); const float rs = rsqrtf(ss * (1.f / 2048.f) + 1e-6f);
#pragma unroll
            for (int i = 0; i < 8; ++i) { const float4 gg = ((const float4*)gain)[i * 64 + lane]; float4 w = v[i]; w.x *= rs * gg.x; w.y *= rs * gg.y; w.z *= rs * gg.z; w.w *= rs * gg.w; pr[i * 64 + lane] = w; }
        }
    }
}

extern "C" void kernel_launch(void* const* d_in, const int* in_sizes, int n_in, void* d_out, int out_size, void* d_ws, size_t ws_size, hipStream_t stream) {
    Params p{};
    for (int i = 0; i < 30; ++i) p.in[i] = (const float*)d_in[i];
    p.out = (float*)d_out; p.ws = (unsigned char*)d_ws;
#ifdef ONE_LAUNCH
    static int grid_blocks = 0;
    if (!grid_blocks) {
        (void)hipFuncSetAttribute((const void*)mega<PH_ALL>, hipFuncAttributeMaxDynamicSharedMemorySize, LDS_BYTES);
        int dev = 0, cus = 0, per_cu = 0;
        (void)hipGetDevice(&dev);
        (void)hipDeviceGetAttribute(&cus, hipDeviceAttributeMultiprocessorCount, dev);
        (void)hipOccupancyMaxActiveBlocksPerMultiprocessor(&per_cu, mega<PH_ALL>, 512, LDS_BYTES);
        grid_blocks = (cus * per_cu >= 256) ? 256 : cus * per_cu;
    }
    int lo = 0, hi = NSEG;
    void* args[] = {&p, &lo, &hi};
    hipError_t e = hipLaunchCooperativeKernel((void*)mega<PH_ALL>, dim3(grid_blocks), dim3(512), args, LDS_BYTES, stream);
    if (e != hipSuccess) fprintf(stderr, "cooperative launch failed: %s (grid %d)\n", hipGetErrorString(e), grid_blocks);
#else
    static int init = 0;
#define SETA(PHV) (void)hipFuncSetAttribute((const void*)mega<PHV>, hipFuncAttributeMaxDynamicSharedMemorySize, LDS_BYTES)
    if (!init) { init = 1; SETA(1u); SETA(2u); SETA(4u); SETA(8u); SETA(16u); SETA(32u); SETA(64u); SETA(128u); SETA(256u); SETA(512u); SETA(1024u); SETA(2048u); SETA(4096u); }
#define L(PHV, lo, hi) mega<PHV><<<256, 512, LDS_BYTES, stream>>>(p, lo, hi)
    L(1u, 0, 0);
    for (int s = 0; s < NSEG; ++s) { L(2u, s, s + 1); L(4u, s, s + 1); L(8u, s, s + 1); }
    L(16u, 0, 0); L(32u, 0, 0); L(64u, 0, 0); L(128u, 0, 0); L(256u, 0, 0); L(512u, 0, 0); L(1024u, 0, 0); L(2048u, 0, 0); L(4096u, 0, 0);
#endif
}
```

```cpp
#include <hip/hip_runtime.h>
#ifndef MULTI_LAUNCH
#define ONE_LAUNCH 1
#endif
#include <hip/hip_cooperative_groups.h>
#include <cstdio>
namespace cg = cooperative_groups;

#define LAS __attribute__((address_space(3)))
typedef unsigned short bf16_t;
typedef short bf16x8 __attribute__((ext_vector_type(8)));
typedef float f32x4 __attribute__((ext_vector_type(4)));
typedef float f32x2 __attribute__((ext_vector_type(2)));
typedef unsigned u32x4 __attribute__((ext_vector_type(4)));

constexpr int T = 16384, D = 2048, NIN = 7472, NINP = 7680, DFF = 8192;
constexpr int GDN_COLS = 4112, RW0 = 4112;
constexpr int SEG = 2048, NSEG = 8;
constexpr int RREC = 384, GREC = 388;

constexpr size_t al(size_t x) { return (x + 255) & ~(size_t)255; }
constexpr size_t OFF_WIN = 0;
constexpr size_t OFF_WOUT = OFF_WIN + (size_t)NINP * D * 2;
constexpr size_t OFF_WQ = OFF_WOUT + (size_t)D * D * 2;
constexpr size_t OFF_WK = OFF_WQ + (size_t)D * D * 2;
constexpr size_t OFF_WV = OFF_WK + (size_t)D * D * 2;
constexpr size_t OFF_WO = OFF_WV + (size_t)D * D * 2;
constexpr size_t OFF_WUP = OFF_WO + (size_t)D * D * 2;
constexpr size_t OFF_WDN = OFF_WUP + (size_t)DFF * D * 2;
constexpr size_t OFF_MN = OFF_WDN + (size_t)DFF * D * 2;
constexpr size_t OFF_KX = OFF_MN + (size_t)256 * D * 2;
constexpr size_t OFF_VT = OFF_KX + (size_t)256 * D * 2;
constexpr size_t OFF_RSTDX = OFF_VT + (size_t)256 * D * 2;
constexpr size_t OFF_SSQ1 = OFF_RSTDX + (size_t)T * 4;
constexpr size_t OFF_SSQ2 = OFF_SSQ1 + (size_t)T * 32 * 4;
constexpr size_t OFF_PROW = OFF_SSQ2 + (size_t)T * 32 * 4;
constexpr size_t OFF_CARRY = OFF_PROW + (size_t)T * 16 * 4;
constexpr size_t OFF_SG = OFF_CARRY + al((size_t)2 * 3 * NINP * 4);
constexpr size_t OFF_SR = OFF_SG + (size_t)8 * 128 * 128 * 4;
constexpr size_t OFF_AB0 = OFF_SR + (size_t)16 * 64 * 64 * 4;
constexpr size_t OFF_AB1 = OFF_AB0 + (size_t)T * D * 2;
constexpr size_t OFF_BIG = OFF_AB1 + (size_t)T * D * 2;
constexpr size_t OFF_YSEG = OFF_BIG;
constexpr size_t OFF_RREC = OFF_YSEG + (size_t)SEG * NINP * 4;
constexpr size_t OFF_GREC = OFF_RREC + (size_t)SEG * 16 * RREC * 4;
constexpr int NTASK = (SEG / 64) * 8;
constexpr size_t OFF_PM = OFF_GREC;
constexpr size_t OFF_RN = OFF_PM + (size_t)NTASK * 16384 * 2;
constexpr size_t OFF_QP = OFF_RN + (size_t)NTASK * 16384 * 4;
constexpr size_t OFF_OL = OFF_QP + (size_t)NTASK * 8192 * 2;
constexpr size_t OFF_SH = OFF_OL + (size_t)NTASK * 8192 * 4;
constexpr size_t OFF_EG = OFF_SH + (size_t)NTASK * 16384 * 2;
constexpr size_t OFF_UW = OFF_EG + 4096;
constexpr size_t OFF_BONUS = OFF_UW + (size_t)NTASK * 16384 * 4;
constexpr size_t OFF_GATE = OFF_BONUS + (size_t)SEG * 1024 * 4;
constexpr size_t OFF_SZ = OFF_GATE + (size_t)SEG * 1024 * 4;
constexpr size_t OFF_ORW = OFF_SZ + (size_t)SEG * 1024 * 4;
constexpr size_t OFF_OGD = OFF_ORW + (size_t)SEG * 1024 * 4;
constexpr int RTASK = (SEG / 64) * 16;
constexpr size_t OFF_RPM = OFF_OGD;
constexpr size_t OFF_RRM = OFF_RPM + (size_t)RTASK * 4096 * 2;
constexpr size_t OFF_RQP = OFF_RRM + (size_t)RTASK * 4096 * 4;
constexpr size_t OFF_ROL = OFF_RQP + (size_t)RTASK * 4096 * 2;
constexpr size_t OFF_RZH = OFF_ROL + (size_t)RTASK * 4096 * 4;
constexpr size_t OFF_RPC = OFF_RZH + (size_t)RTASK * 4096 * 2;
constexpr size_t OFF_XS = OFF_RPC + (size_t)RTASK * 64 * 4;
constexpr size_t OFF_END1 = OFF_XS + (size_t)256 * 8192 * 4;
constexpr size_t OFF_BAR = OFF_END1;
constexpr size_t OFF_U = OFF_AB1;
constexpr size_t OFF_END2 = OFF_U + (size_t)T * DFF * 2;
static_assert(OFF_BAR + 16384 <= 536870912ull, "ws overflow 1");
static_assert(OFF_END2 <= 536870912ull, "ws overflow 2");

constexpr int LDS_BYTES = 163840;
constexpr int RC_AAB = 0, RC_PS = 16384, RC_ATF = 18432, RC_RTF = 35840, RC_ATB = 53248, RC_RTB = 62464, RC_BIB = 71680, RC_KIB = 80896, RC_BTT = 90112, RC_KTT = 99328, RC_VT = 108544, RC_AAK = 117760, RC_ARB = 126976, RC_ARK = 136192, RC_CMF = 145408;
constexpr int GP_SM = 0, GP_MM = 1024, GP_AM = 17408, GP_QF = 33792, GP_KF = 67584, GP_VF = 101376, GP_KTT = 135168, GP_AB = 153600;

struct Params {
    const float* in[30];
    float* out;
    unsigned char* ws;
};

__device__ __forceinline__ bf16_t f2bf(float f) { unsigned u = __float_as_uint(f); u += 0x7FFFu + ((u >> 16) & 1u); return (bf16_t)(u >> 16); }
typedef __bf16 bf16v2 __attribute__((ext_vector_type(2)));
__device__ __forceinline__ unsigned pack2(float a, float b) { const f32x2 v = (f32x2){a, b}; const bf16v2 h = __builtin_convertvector(v, bf16v2); return __builtin_bit_cast(unsigned, h); }
__device__ __forceinline__ f32x4 mfma16(bf16x8 a, bf16x8 b, f32x4 c) { return __builtin_amdgcn_mfma_f32_16x16x32_bf16(a, b, c, 0, 0, 0); }
__device__ __forceinline__ float sigmoidf_(float x) { return 1.f / (1.f + __expf(-x)); }
__device__ __forceinline__ float softplusf_(float x) { return x > 20.f ? x : log1pf(__expf(x)); }
__device__ __forceinline__ float siluf_(float x) { return x / (1.f + __expf(-x)); }
template <int CTRL> __device__ __forceinline__ float dppf(float x) { return __int_as_float(__builtin_amdgcn_update_dpp(0, __float_as_int(x), CTRL, 0xF, 0xF, false)); }
__device__ __forceinline__ float allred16(float x) {
    x += dppf<0xB1>(x);
    x += dppf<0x4E>(x);
    x += dppf<0x124>(x);
    x += dppf<0x128>(x);
    return x;
}
__device__ __forceinline__ float wsum(float v) { v = allred16(v); v += __shfl_xor(v, 16); v += __shfl_xor(v, 32); return v; }

__device__ __forceinline__ int lbid() { int b = blockIdx.x; asm volatile("" : "+v"(b)); return __builtin_amdgcn_readfirstlane(b); }
__device__ __forceinline__ int ltid() { int t = threadIdx.x; asm volatile("" : "+v"(t)); return t; }


#define XB_TMO      128
#define XB_XCNT(j)  (256  + 64 * (j))
#define XB_XSUB(j)  (1280 + 64 * (j))
#define XB_XGEN(j)  (2304 + 64 * (j))
#define XB_TOP      3328
#define XB_TOPGEN   3392
#define XCD_BAR_WORDS 3456
#define XB_SPIN_CAP (1u << 22)
__device__ __forceinline__ unsigned xb_ld(unsigned* p)              { return __hip_atomic_load(p, __ATOMIC_RELAXED, __HIP_MEMORY_SCOPE_AGENT); }
__device__ __forceinline__ unsigned xb_add(unsigned* p, unsigned v) { return __hip_atomic_fetch_add(p, v, __ATOMIC_RELAXED, __HIP_MEMORY_SCOPE_AGENT); }
__device__ __forceinline__ unsigned xb_xcc_id() { return (unsigned)__builtin_amdgcn_s_getreg((3 << 11) | 20) & 0xFu; }
#define XB_SPIN(cond, bar) do { unsigned _sp = 0; while (cond) { __builtin_amdgcn_s_sleep(1); \
    if ((++_sp & 255u) == 0u) { if (xb_ld(&(bar)[XB_TMO])) break; if (_sp > XB_SPIN_CAP) { atomicAdd(&(bar)[XB_TMO], 1u); break; } } } } while (0)
struct XcdBarrier { unsigned* bar; unsigned x; volatile LAS unsigned* st; };
__device__ __forceinline__ XcdBarrier xcd_barrier_post(unsigned* bar, volatile LAS unsigned* st) {
    XcdBarrier b; b.bar = bar; b.x = xb_xcc_id(); b.st = st;
    if (threadIdx.x == 0) (void)xb_add(&bar[XB_XCNT(b.x)], 1u);
    return b;
}
__device__ __forceinline__ void xcd_barrier_complete(unsigned* bar, unsigned x, unsigned& nloc, unsigned& nx) {
    const unsigned G = gridDim.x * gridDim.y * gridDim.z;
    unsigned sum, cnt, mine, sp = 0u;
    for (;;) {
        sum = 0u; cnt = 0u; mine = 0u;
#pragma unroll
        for (unsigned j = 0; j < 16; ++j) { const unsigned c = xb_ld(&bar[XB_XCNT(j)]); sum += c; cnt += (c > 0u) ? 1u : 0u; mine = (j == x) ? c : mine; }
        if (sum == G) break;
        __builtin_amdgcn_s_sleep(1);
        if ((++sp & 255u) == 0u) { if (xb_ld(&bar[XB_TMO])) break; if (sp > XB_SPIN_CAP) { atomicAdd(&bar[XB_TMO], 1u); break; } }
    }
    nloc = mine > 0u ? mine : 1u; nx = cnt > 0u ? cnt : 1u;
}
__device__ __forceinline__ void xcd_barrier(const XcdBarrier& b) {
    asm volatile("s_waitcnt vmcnt(0)" ::: "memory");
    __syncthreads();
    if (threadIdx.x == 0) {
        unsigned* bar = b.bar;
        __builtin_amdgcn_s_waitcnt(0);
        unsigned nloc = b.st[0], nx = b.st[1];
        if (nloc == 0u) { xcd_barrier_complete(bar, b.x, nloc, nx); b.st[0] = nloc; b.st[1] = nx; }
        const unsigned old = xb_add(&bar[XB_XSUB(b.x)], 1u);
        const unsigned gen = old / nloc;
        if (old + 1u == (gen + 1u) * nloc) {
            __builtin_amdgcn_fence(__ATOMIC_RELEASE, "agent");
            asm volatile("s_waitcnt vmcnt(0)" ::: "memory");
            const unsigned og = xb_add(&bar[XB_TOP], 1u);
            const unsigned tg = og / nx;
            if (og + 1u == (tg + 1u) * nx) xb_add(&bar[XB_TOPGEN], 1u);
            else XB_SPIN(xb_ld(&bar[XB_TOPGEN]) == tg, bar);
            __builtin_amdgcn_fence(__ATOMIC_ACQUIRE, "agent");
            xb_add(&bar[XB_XGEN(b.x)], 1u);
            asm volatile("s_waitcnt vmcnt(0)" ::: "memory");
        } else {
            XB_SPIN(xb_ld(&bar[XB_XGEN(b.x)]) == gen, bar);
            __builtin_amdgcn_fence(__ATOMIC_ACQUIRE, "agent");
            asm volatile("s_waitcnt vmcnt(0)" ::: "memory");
        }
    }
    __syncthreads();
}

namespace pg8 {
constexpr int BM = 256, BK = 64, HALF = 128, HTB = HALF * BK * 2, NXCD = 8, WGM = 8;
__device__ __forceinline__ int lds_byte(int r, int c) { const int st = (r >> 4) * 2 + (c >> 5), rr = r & 15, cc = c & 31, ob = rr * 64 + cc * 2; return st * 1024 + (ob ^ (((ob >> 9) & 1) << 5)); }
__device__ __forceinline__ int perm32(int rho) { const int n = rho >> 4, i = rho & 15; return 8 * (i >> 2) + 4 * n + (i & 3); }
__device__ __forceinline__ void stage_rc(int b, int& R, int& C) { const int st = b / 1024, sb = b % 1024, swz = sb ^ (((sb >> 9) & 1) << 5); R = (st >> 1) * 16 + swz / 64; C = (st & 1) * 32 + (swz % 64) / 2; }

struct Unit { int pm, pn, b; };
struct Gemm { const bf16_t* A; const bf16_t* Bt; int lda, ldb, K, nM, nN, nB; size_t sA, sB; };

struct Order {
    int nM, nN, per, nwg, G, c;
    __device__ void init(const Gemm& g, int G_, int c_) { nM = g.nM; nN = g.nN; per = nM * nN; nwg = per * g.nB; G = G_; c = c_; }
    __device__ bool next(int i, Unit& u) const {
        const long L = (long)i * G + c; if (L >= nwg) return false;
        u.b = (int)(L / per); int wgid = (int)(L % per);
        { const int q = per / NXCD, r = per % NXCD, xcd = wgid % NXCD, off = wgid / NXCD; wgid = (xcd < r ? xcd * (q + 1) : r * (q + 1) + (xcd - r) * q) + off; }
        const int nig = WGM * nN, gid = wgid / nig, fm = gid * WGM, gsz = (nM - fm) < WGM ? (nM - fm) : WGM;
        u.pm = fm + ((wgid % nig) % gsz); u.pn = (wgid % nig) / gsz; return true;
    }
};

template <class Epi>
__device__ __forceinline__ void gemm_phase(LAS unsigned char* lds, const Gemm g, const Order& S, const Epi& E) {
    int tid_ = threadIdx.x; asm volatile("" : "+v"(tid_));
    const int tid = tid_, wid = __builtin_amdgcn_readfirstlane(tid >> 6), lane = tid & 63, wr = wid >> 2, wc = wid & 3, fr = lane & 15, fq = lane >> 4;
    const int K = g.K, nt = K / BK;
    unsigned voffA[2], voffB[2];
#pragma unroll
    for (int i = 0; i < 2; ++i) { int R, C; stage_rc(tid * 16 + i * 8192, R, C);
        const int Rb = Epi::PERM ? ((R & ~31) + perm32(R & 31)) : R;
        voffA[i] = (unsigned)(R * g.lda + C) * 2u; voffB[i] = (unsigned)(Rb * g.ldb + C) * 2u; }
    const size_t kstep = (size_t)(BK * 2);
    const size_t hstepA = (size_t)HALF * g.lda * 2, hstepB = (size_t)HALF * g.ldb * 2;
    const size_t tstepA = 2 * hstepA, tstepB = 2 * hstepB;
    const unsigned ldsw = (unsigned)wid * 1024u;
    const int aoff = lds_byte(wr * 64 + fr, fq * 8), boff = lds_byte(wc * 32 + fr, fq * 8);
#define PG8_SA(b, h) (((b) * 2 + (h)) * HTB)
#define PG8_SB(b, h) ((4 + (b) * 2 + (h)) * HTB)
#define PG8_STAGE(bufoff, gbase, voff) do { _Pragma("unroll") for (int _i = 0; _i < 2; ++_i) \
        __builtin_amdgcn_global_load_lds((const unsigned*)((const char*)(gbase) + (voff)[_i]), (LAS unsigned*)(lds + (bufoff) + ldsw + _i * 8192), 16, 0, 0); } while (0)
#define PG8_LDA(dst, b, h) do { _Pragma("unroll") for (int m = 0; m < 4; ++m) _Pragma("unroll") for (int k = 0; k < 2; ++k) dst[m][k] = *(const LAS bf16x8*)(lds + PG8_SA(b, h) + aoff + m * 2048 + k * 1024); } while (0)
#define PG8_LDB(dst, b, h) do { _Pragma("unroll") for (int n = 0; n < 2; ++n) _Pragma("unroll") for (int k = 0; k < 2; ++k) dst[n][k] = *(const LAS bf16x8*)(lds + PG8_SB(b, h) + boff + n * 2048 + k * 1024); } while (0)
#define PG8_MMA(ai, bj, At, Bt) do { __builtin_amdgcn_s_setprio(1); _Pragma("unroll") for (int m = 0; m < 4; ++m) _Pragma("unroll") for (int n = 0; n < 2; ++n) _Pragma("unroll") for (int k = 0; k < 2; ++k) \
        acc[ai][bj][m][n] = __builtin_amdgcn_mfma_f32_16x16x32_bf16(Bt[n][k], At[m][k], acc[ai][bj][m][n], 0, 0, 0); __builtin_amdgcn_s_setprio(0); } while (0)
#define PG8_WAIT_V(n) asm volatile("s_waitcnt vmcnt(" #n ")" ::: "memory")
#define PG8_WAIT_L(n) asm volatile("s_waitcnt lgkmcnt(" #n ")" ::: "memory")
#define PG8_BAR __builtin_amdgcn_s_barrier()
#define PG8_SCHED __builtin_amdgcn_sched_barrier(0)
    Unit cur, nxt; int ui = 0;
    if (!S.next(0, cur)) return;
    f32x4 acc[2][2][4][2];
#pragma unroll
    for (int a = 0; a < 2; ++a)
#pragma unroll
        for (int b = 0; b < 2; ++b)
#pragma unroll
            for (int m = 0; m < 4; ++m)
#pragma unroll
                for (int n = 0; n < 2; ++n) acc[a][b][m][n] = (f32x4){0.f, 0.f, 0.f, 0.f};
    bf16x8 At[4][2], B0[2][2], B1[2][2];
    const char* cA = (const char*)g.A + (size_t)cur.b * g.sA * 2 + (size_t)cur.pm * tstepA; const char* cB = (const char*)g.Bt + (size_t)cur.b * g.sB * 2 + (size_t)cur.pn * tstepB;
    PG8_STAGE(PG8_SB(0, 0), cB, voffB); PG8_STAGE(PG8_SA(0, 0), cA, voffA); PG8_STAGE(PG8_SB(0, 1), cB + hstepB, voffB); PG8_STAGE(PG8_SA(0, 1), cA + hstepA, voffA);
    if (wr == 1) PG8_BAR;
    PG8_WAIT_V(4); PG8_BAR;
    PG8_STAGE(PG8_SB(1, 0), cB + kstep, voffB); PG8_STAGE(PG8_SA(1, 0), cA + kstep, voffA); PG8_STAGE(PG8_SB(1, 1), cB + hstepB + kstep, voffB);
    PG8_WAIT_V(6); PG8_BAR;
    for (;;) {
        const bool has_next = S.next(ui + 1, nxt);
        const char* nA = has_next ? (const char*)g.A + (size_t)nxt.b * g.sA * 2 + (size_t)nxt.pm * tstepA : cA; const char* nB = has_next ? (const char*)g.Bt + (size_t)nxt.b * g.sB * 2 + (size_t)nxt.pn * tstepB : cB;
        for (int t = 0; t < nt; t += 2) {
            const bool last = (t == nt - 2);
            const char* a1 = cA + (size_t)(t + 1) * kstep;
            const char* a2 = last ? nA : cA + (size_t)(t + 2) * kstep; const char* b2 = last ? nB : cB + (size_t)(t + 2) * kstep;
            const char* a3 = a2 + kstep; const char* b3 = b2 + kstep;
            PG8_LDB(B0, 0, 0); PG8_SCHED; PG8_LDA(At, 0, 0); PG8_STAGE(PG8_SA(1, 1), a1 + hstepA, voffA);
            PG8_WAIT_L(8); PG8_BAR; PG8_WAIT_L(0); PG8_MMA(0, 0, At, B0); PG8_BAR; PG8_SCHED;
            PG8_LDB(B1, 0, 1); PG8_STAGE(PG8_SB(0, 0), b2, voffB);
            PG8_BAR; PG8_WAIT_L(0); PG8_MMA(0, 1, At, B1); PG8_BAR;
            PG8_LDA(At, 0, 1); PG8_STAGE(PG8_SA(0, 0), a2, voffA);
            PG8_BAR; PG8_WAIT_L(0); PG8_MMA(1, 0, At, B0); PG8_BAR; PG8_SCHED;
            PG8_STAGE(PG8_SB(0, 1), b2 + hstepB, voffB);
            PG8_WAIT_V(6); PG8_BAR; PG8_MMA(1, 1, At, B1); PG8_BAR;
            PG8_LDB(B0, 1, 0); PG8_SCHED; PG8_LDA(At, 1, 0); PG8_STAGE(PG8_SA(0, 1), a2 + hstepA, voffA);
            PG8_WAIT_L(8); PG8_BAR; PG8_WAIT_L(0); PG8_MMA(0, 0, At, B0); PG8_BAR; PG8_SCHED;
            PG8_LDB(B1, 1, 1); PG8_STAGE(PG8_SB(1, 0), b3, voffB);
            PG8_BAR; PG8_WAIT_L(0); PG8_MMA(0, 1, At, B1); PG8_BAR;
            PG8_LDA(At, 1, 1); PG8_STAGE(PG8_SA(1, 0), a3, voffA);
            PG8_BAR; PG8_WAIT_L(0); PG8_MMA(1, 0, At, B0); PG8_BAR; PG8_SCHED;
            PG8_STAGE(PG8_SB(1, 1), b3 + hstepB, voffB);
            PG8_WAIT_V(6); PG8_BAR; PG8_MMA(1, 1, At, B1); PG8_BAR;
        }
        E(acc, cur, wr, wc, fr, fq);
        if (!has_next) break;
#pragma unroll
        for (int a = 0; a < 2; ++a)
#pragma unroll
            for (int b = 0; b < 2; ++b)
#pragma unroll
                for (int m = 0; m < 4; ++m)
#pragma unroll
                    for (int n = 0; n < 2; ++n) acc[a][b][m][n] = (f32x4){0.f, 0.f, 0.f, 0.f};
        cur = nxt; cA = nA; cB = nB; ++ui;
    }
    PG8_WAIT_V(0);
    if (wr == 0) PG8_BAR;
    PG8_BAR;
#undef PG8_SA
#undef PG8_SB
#undef PG8_STAGE
#undef PG8_LDA
#undef PG8_LDB
#undef PG8_MMA
#undef PG8_WAIT_V
#undef PG8_WAIT_L
#undef PG8_BAR
#undef PG8_SCHED
}
}
using pg8::Unit;
using pg8::Gemm;

__device__ __forceinline__ float rs_from(const float* ssq, int row) {
    const float4* p = (const float4*)(ssq + (size_t)row * 32); float s = 0.f;
#pragma unroll
    for (int i = 0; i < 8; ++i) { float4 v = p[i]; s += (v.x + v.y) + (v.z + v.w); }
    return rsqrtf(s * (1.f / 2048.f) + 1e-6f);
}
__device__ __forceinline__ void rs8_from(const float* ssq, int row0, int fq, float (&rs)[8]) {
    float4 pa[8], pb[8];
#pragma unroll
    for (int i = 0; i < 8; ++i) { const float4* p4 = (const float4*)(ssq + (size_t)(row0 + (i >> 2) * 128 + (i & 3) * 16) * 32) + fq * 2; pa[i] = p4[0]; pb[i] = p4[1]; }
#pragma unroll
    for (int i = 0; i < 8; ++i) { float v = ((pa[i].x + pa[i].y) + (pa[i].z + pa[i].w)) + ((pb[i].x + pb[i].y) + (pb[i].z + pb[i].w));
        v += __shfl_xor(v, 16); v += __shfl_xor(v, 32); rs[i] = rsqrtf(v * (1.f / 2048.f) + 1e-6f); }
}
__device__ __forceinline__ void rs8_cached(const float* ssq, LAS float* cache, int pm, int row0, int wr, int wc, int fr, int fq, float (&rs)[8]) {
    LAS float* sl = cache + (((wr * 4 + wc) * 64) + fq * 16 + fr) * 12;
    if (__float_as_int(sl[0]) == pm) {
        const f32x4 a = *(const LAS f32x4*)(sl + 4), b = *(const LAS f32x4*)(sl + 8);
        rs[0] = a[0]; rs[1] = a[1]; rs[2] = a[2]; rs[3] = a[3]; rs[4] = b[0]; rs[5] = b[1]; rs[6] = b[2]; rs[7] = b[3];
    } else {
        rs8_from(ssq, row0, fq, rs);
        *(LAS f32x4*)(sl + 4) = (f32x4){rs[0], rs[1], rs[2], rs[3]}; *(LAS f32x4*)(sl + 8) = (f32x4){rs[4], rs[5], rs[6], rs[7]};
        sl[0] = __int_as_float(pm);
    }
}
struct EpiY {
    static constexpr bool PERM = false;
    float* Y; int ldc; const float* rstd;
    __device__ __forceinline__ void operator()(const f32x4 (&acc)[2][2][4][2], const Unit& u, int wr, int wc, int fr, int fq) const {
        const int row0 = u.pm * 256 + wr * 64 + fr, col0 = u.pn * 256 + wc * 32 + 4 * fq;
        float rs[8];
#pragma unroll
        for (int i = 0; i < 8; ++i) rs[i] = rstd[row0 + (i >> 2) * 128 + (i & 3) * 16];
        __builtin_amdgcn_sched_barrier(0);
#pragma unroll
        for (int ai = 0; ai < 2; ++ai)
#pragma unroll
            for (int m = 0; m < 4; ++m) { const int row = row0 + ai * 128 + m * 16; float* rowp = Y + (size_t)row * ldc + col0;
#pragma unroll
                for (int bj = 0; bj < 2; ++bj)
#pragma unroll
                    for (int n = 0; n < 2; ++n) *(f32x4*)(rowp + bj * 128 + n * 16) = acc[ai][bj][m][n] * rs[ai * 4 + m]; }
    }
};
__device__ __forceinline__ uint4 pack8(f32x4 a, f32x4 b) { uint4 o; o.x = pack2(a[0], a[1]); o.y = pack2(a[2], a[3]); o.z = pack2(b[0], b[1]); o.w = pack2(b[2], b[3]); return o; }
struct EpiBf {
    static constexpr bool PERM = true;
    bf16_t* O; int ldc; const float* ssq; LAS float* cache;
    __device__ __forceinline__ void operator()(const f32x4 (&acc)[2][2][4][2], const Unit& u, int wr, int wc, int fr, int fq) const {
        const int row0 = u.pm * 256 + wr * 64 + fr, col0 = u.pn * 256 + wc * 32 + 8 * fq;
        float rs[8];
        if (ssq) rs8_cached(ssq, cache, u.pm, row0, wr, wc, fr, fq, rs); else {
#pragma unroll
            for (int i = 0; i < 8; ++i) rs[i] = 1.f; }
        __builtin_amdgcn_sched_barrier(0);
#pragma unroll
        for (int ai = 0; ai < 2; ++ai)
#pragma unroll
            for (int m = 0; m < 4; ++m) { const int row = row0 + ai * 128 + m * 16; bf16_t* rowp = O + (size_t)row * ldc + col0; const float r1 = rs[ai * 4 + m];
#pragma unroll
                for (int bj = 0; bj < 2; ++bj) *(uint4*)(rowp + bj * 128) = pack8(acc[ai][bj][m][0] * r1, acc[ai][bj][m][1] * r1); }
    }
};
struct EpiUp {
    static constexpr bool PERM = true;
    bf16_t* O; int ldc; const float* ssq; LAS float* cache;
    __device__ __forceinline__ void operator()(const f32x4 (&acc)[2][2][4][2], const Unit& u, int wr, int wc, int fr, int fq) const {
        const int row0 = u.pm * 256 + wr * 64 + fr, col0 = u.pn * 256 + wc * 32 + 8 * fq;
        float rs[8];
        rs8_cached(ssq, cache, u.pm, row0, wr, wc, fr, fq, rs);
        __builtin_amdgcn_sched_barrier(0);
#pragma unroll
        for (int ai = 0; ai < 2; ++ai)
#pragma unroll
            for (int m = 0; m < 4; ++m) { const int row = row0 + ai * 128 + m * 16; bf16_t* rowp = O + (size_t)row * ldc + col0; const float r1 = rs[ai * 4 + m];
#pragma unroll
                for (int bj = 0; bj < 2; ++bj) { f32x4 v0 = acc[ai][bj][m][0] * r1, v1 = acc[ai][bj][m][1] * r1;
#pragma unroll
                    for (int j = 0; j < 4; ++j) { const float a = fmaxf(v0[j], 0.f), b = fmaxf(v1[j], 0.f); v0[j] = a * a; v1[j] = b * b; }
                    *(uint4*)(rowp + bj * 128) = pack8(v0, v1); } }
    }
};
template <bool WH32, bool WHB> struct EpiRes {
    static constexpr bool PERM = !WH32;
    const bf16_t* Rb; float* H; bf16_t* HB; float* ssq;
    __device__ __forceinline__ void operator()(const f32x4 (&acc)[2][2][4][2], const Unit& u, int wr, int wc, int fr, int fq) const {
        const int row0 = u.pm * 256 + wr * 64 + fr;
        if constexpr (PERM) {
            const int col0 = u.pn * 256 + wc * 32 + 8 * fq;
#pragma unroll
            for (int ai = 0; ai < 2; ++ai) {
                uint4 rv[4][2];
#pragma unroll
                for (int m = 0; m < 4; ++m)
#pragma unroll
                    for (int bj = 0; bj < 2; ++bj) rv[m][bj] = *(const uint4*)(Rb + (size_t)(row0 + ai * 128 + m * 16) * 2048 + col0 + bj * 128);
                __builtin_amdgcn_sched_barrier(0);
#pragma unroll
                for (int m = 0; m < 4; ++m) { const int row = row0 + ai * 128 + m * 16; const size_t ro = (size_t)row * 2048 + col0; float s = 0.f;
#pragma unroll
                    for (int bj = 0; bj < 2; ++bj) { const uint4 rb = rv[m][bj]; f32x4 v0 = acc[ai][bj][m][0], v1 = acc[ai][bj][m][1];
                        v0[0] += __uint_as_float(rb.x << 16); v0[1] += __uint_as_float(rb.x & 0xFFFF0000u); v0[2] += __uint_as_float(rb.y << 16); v0[3] += __uint_as_float(rb.y & 0xFFFF0000u);
                        v1[0] += __uint_as_float(rb.z << 16); v1[1] += __uint_as_float(rb.z & 0xFFFF0000u); v1[2] += __uint_as_float(rb.w << 16); v1[3] += __uint_as_float(rb.w & 0xFFFF0000u);
                        s += (v0[0] * v0[0] + v0[1] * v0[1] + v0[2] * v0[2] + v0[3] * v0[3]) + (v1[0] * v1[0] + v1[1] * v1[1] + v1[2] * v1[2] + v1[3] * v1[3]);
                        if (WHB) *(uint4*)(HB + ro + bj * 128) = pack8(v0, v1); }
                    if (ssq) { s += __shfl_xor(s, 16); s += __shfl_xor(s, 32); if (fq == 0) ssq[(size_t)row * 32 + u.pn * 4 + wc] = s; } }
                __builtin_amdgcn_sched_barrier(0);
            }
        } else {
            const int col0 = u.pn * 256 + wc * 32 + 4 * fq;
#pragma unroll
            for (int ai = 0; ai < 2; ++ai) {
                uint2 rv[4][2][2];
#pragma unroll
                for (int m = 0; m < 4; ++m)
#pragma unroll
                    for (int bj = 0; bj < 2; ++bj)
#pragma unroll
                        for (int n = 0; n < 2; ++n) rv[m][bj][n] = *(const uint2*)(Rb + (size_t)(row0 + ai * 128 + m * 16) * 2048 + col0 + bj * 128 + n * 16);
                __builtin_amdgcn_sched_barrier(0);
#pragma unroll
                for (int m = 0; m < 4; ++m) { const int row = row0 + ai * 128 + m * 16; const size_t ro = (size_t)row * 2048 + col0; float s = 0.f;
#pragma unroll
                    for (int bj = 0; bj < 2; ++bj)
#pragma unroll
                        for (int n = 0; n < 2; ++n) { const size_t o = ro + bj * 128 + n * 16; const uint2 rb = rv[m][bj][n];
                            f32x4 v = acc[ai][bj][m][n];
                            v[0] += __uint_as_float(rb.x << 16); v[1] += __uint_as_float(rb.x & 0xFFFF0000u); v[2] += __uint_as_float(rb.y << 16); v[3] += __uint_as_float(rb.y & 0xFFFF0000u);
                            if (WH32) *(f32x4*)(H + o) = v;
                            s += v[0] * v[0] + v[1] * v[1] + v[2] * v[2] + v[3] * v[3]; }
                    if (ssq) { s += __shfl_xor(s, 16); s += __shfl_xor(s, 32); if (fq == 0) ssq[(size_t)row * 32 + u.pn * 4 + wc] = s; } }
                __builtin_amdgcn_sched_barrier(0);
            }
        }
    }
};
struct EpiScore {
    static constexpr bool PERM = true;
    bf16_t* P; float* prow; float scale;
    __device__ __forceinline__ void operator()(const f32x4 (&acc)[2][2][4][2], const Unit& u, int wr, int wc, int fr, int fq) const {
        const int row0 = u.pm * 256 + wr * 64 + fr, col0 = u.b * 256 + wc * 32 + 8 * fq;
#pragma unroll
        for (int ai = 0; ai < 2; ++ai)
#pragma unroll
            for (int m = 0; m < 4; ++m) { const int row = row0 + ai * 128 + m * 16; bf16_t* rowp = P + (size_t)row * 1024 + col0; float s = 0.f;
#pragma unroll
                for (int bj = 0; bj < 2; ++bj) { f32x4 v0 = acc[ai][bj][m][0] * scale, v1 = acc[ai][bj][m][1] * scale;
#pragma unroll
                    for (int j = 0; j < 4; ++j) { v0[j] = __expf(fminf(v0[j], 80.f)); v1[j] = __expf(fminf(v1[j], 80.f)); s += v0[j] + v1[j]; }
                    *(uint4*)(rowp + bj * 128) = pack8(v0, v1); }
                s += __shfl_xor(s, 16); s += __shfl_xor(s, 32); if (fq == 0) prow[(size_t)row * 16 + u.b * 4 + wc] = s; }
    }
};
struct EpiPV {
    static constexpr bool PERM = true;
    bf16_t* O; const float* prow;
    __device__ __forceinline__ void operator()(const f32x4 (&acc)[2][2][4][2], const Unit& u, int wr, int wc, int fr, int fq) const {
        const int row0 = u.pm * 256 + wr * 64 + fr, col0 = u.b * 512 + u.pn * 256 + wc * 32 + 8 * fq;
        float inv[8];
        { float4 pr[8];
#pragma unroll
          for (int i = 0; i < 8; ++i) pr[i] = *(const float4*)(prow + (size_t)(row0 + (i >> 2) * 128 + (i & 3) * 16) * 16 + u.b * 4);
#pragma unroll
          for (int i = 0; i < 8; ++i) inv[i] = 1.f / ((pr[i].x + pr[i].y) + (pr[i].z + pr[i].w)); }
        __builtin_amdgcn_sched_barrier(0);
#pragma unroll
        for (int ai = 0; ai < 2; ++ai)
#pragma unroll
            for (int m = 0; m < 4; ++m) { const int row = row0 + ai * 128 + m * 16; bf16_t* rowp = O + (size_t)row * 2048 + col0; const float r1 = inv[ai * 4 + m];
#pragma unroll
                for (int bj = 0; bj < 2; ++bj) *(uint4*)(rowp + bj * 128) = pack8(acc[ai][bj][m][0] * r1, acc[ai][bj][m][1] * r1); }
    }
};

template <class Epi>
__device__ __forceinline__ void run_gemm(LAS unsigned char* lds, const bf16_t* A, const bf16_t* Bt, int lda, int ldb, int K, int nM, int nN, int nB, size_t sA, size_t sB, const Epi& E, int cshift, int G = 0, int cc = -1) {
    Gemm g; g.A = A; g.Bt = Bt; g.lda = lda; g.ldb = ldb; g.K = K; g.nM = nM; g.nN = nN; g.nB = nB; g.sA = sA; g.sB = sB;
    pg8::Order S; if (cc >= 0) S.init(g, G, cc); else S.init(g, (int)gridDim.x, (int)((blockIdx.x + cshift) % gridDim.x));
    pg8::gemm_phase<Epi>(lds, g, S, E);
}

__device__ __forceinline__ void convT(const float* __restrict__ src, bf16_t* __restrict__ dst, const float* __restrict__ gain, int K, int N, int Npad, float* tile, int bid = -1, int nb = 0, int t0 = 0, int t1 = 1 << 30) {
    const int tidx = ltid();
    const int tn = Npad / 64; int ntile = (K / 64) * tn; if (t1 < ntile) ntile = t1;
    if (bid < 0) { bid = blockIdx.x; nb = gridDim.x; }
    const int nn = tidx & 63, kb = tidx >> 6, kp = (tidx & 31) * 2, nb2 = tidx >> 5;
    float* tile2 = tile + 64 * 65;
    for (int t = t0 + bid; t < ntile; t += 2 * nb) {
        const int tB = t + nb; const bool hasB = tB < ntile;
        const int k0 = (t / tn) * 64, n0 = (t % tn) * 64, k1 = hasB ? (tB / tn) * 64 : k0, n1 = hasB ? (tB % tn) * 64 : n0;
        float va[8], vb[8];
#pragma unroll
        for (int i = 0; i < 8; ++i) { const int kk = kb + 8 * i;
            va[i] = (n0 + nn < N) ? __builtin_nontemporal_load(src + (size_t)(k0 + kk) * N + n0 + nn) : 0.f;
            vb[i] = (n1 + nn < N) ? __builtin_nontemporal_load(src + (size_t)(k1 + kk) * N + n1 + nn) : 0.f; }
#pragma unroll
        for (int i = 0; i < 8; ++i) { const int kk = kb + 8 * i;
            if (gain) { va[i] *= gain[k0 + kk]; vb[i] *= gain[k1 + kk]; }
            tile[kk * 65 + nn] = va[i]; tile2[kk * 65 + nn] = vb[i]; }
        __syncthreads();
#pragma unroll
        for (int i = 0; i < 4; ++i) { const int n2 = nb2 + 16 * i;
            *(unsigned*)(dst + (size_t)(n0 + n2) * K + k0 + kp) = pack2(tile[kp * 65 + n2], tile[(kp + 1) * 65 + n2]);
            if (hasB) *(unsigned*)(dst + (size_t)(n1 + n2) * K + k1 + kp) = pack2(tile2[kp * 65 + n2], tile2[(kp + 1) * 65 + n2]); }
        __syncthreads();
    }
}
__device__ __forceinline__ void rows_to_bf16(const float* __restrict__ x, bf16_t* __restrict__ xb, float* __restrict__ rstd, const float* __restrict__ gain, int rows) {
    const int tidx = ltid();
    const int gw = blockIdx.x * 8 + (tidx >> 6), nw = gridDim.x * 8, lane = tidx & 63;
    for (int r0 = gw; r0 < rows; r0 += 2 * nw) {
        const int r1 = (r0 + nw < rows) ? r0 + nw : r0;
        const float4* p0 = (const float4*)(x + (size_t)r0 * 2048); const float4* p1 = (const float4*)(x + (size_t)r1 * 2048);
        float4 v0[8], v1[8]; float s0 = 0.f, s1 = 0.f;
#pragma unroll
        for (int i = 0; i < 8; ++i) { const f32x4 a = __builtin_nontemporal_load((const f32x4*)p0 + i * 64 + lane), b = __builtin_nontemporal_load((const f32x4*)p1 + i * 64 + lane);
            v0[i] = make_float4(a[0], a[1], a[2], a[3]); v1[i] = make_float4(b[0], b[1], b[2], b[3]); }
#pragma unroll
        for (int i = 0; i < 8; ++i) { s0 += v0[i].x * v0[i].x + v0[i].y * v0[i].y + v0[i].z * v0[i].z + v0[i].w * v0[i].w; s1 += v1[i].x * v1[i].x + v1[i].y * v1[i].y + v1[i].z * v1[i].z + v1[i].w * v1[i].w; }
        s0 = wsum(s0); s1 = wsum(s1);
        const float rs0 = rsqrtf(s0 * (1.f / 2048.f) + 1e-6f), rs1 = rsqrtf(s1 * (1.f / 2048.f) + 1e-6f);
        if (rstd && lane == 0) { rstd[r0] = rs0; rstd[r1] = rs1; }
#pragma unroll
        for (int i = 0; i < 8; ++i) { float4 w0 = v0[i], w1 = v1[i];
            if (gain) { const float4 gg = ((const float4*)gain)[i * 64 + lane];
                w0.x *= rs0 * gg.x; w0.y *= rs0 * gg.y; w0.z *= rs0 * gg.z; w0.w *= rs0 * gg.w; w1.x *= rs1 * gg.x; w1.y *= rs1 * gg.y; w1.z *= rs1 * gg.z; w1.w *= rs1 * gg.w; }
            uint2 o0, o1; o0.x = pack2(w0.x, w0.y); o0.y = pack2(w0.z, w0.w); o1.x = pack2(w1.x, w1.y); o1.y = pack2(w1.z, w1.w);
            *(uint2*)(xb + (size_t)r0 * 2048 + (size_t)(i * 64 + lane) * 4) = o0; *(uint2*)(xb + (size_t)r1 * 2048 + (size_t)(i * 64 + lane) * 4) = o1; }
    }
}

__device__ __forceinline__ float yget(const float* yseg, const float* carry_prev, int seg, int tl, int col) {
    if (tl >= 0) return yseg[(size_t)tl * NINP + col];
    if (seg == 0) return 0.f;
    return carry_prev[(size_t)(3 + tl) * NINP + col];
}
__device__ __forceinline__ void rwkv_prep_tile(const Params& p, int seg, int cn, int hp, float* act  ) {
    const int tidx = ltid();
    const float* yseg = (const float*)(p.ws + OFF_YSEG);
    const float* carry_prev = (const float*)(p.ws + OFF_CARRY) + (size_t)((seg + 1) & 1) * 3 * NINP;
    const float* mu = p.in[8]; const float* w0 = p.in[9]; const float* w2 = p.in[10]; const float* a0 = p.in[11]; const float* a2 = p.in[12]; const float* g2 = p.in[13];
    const float* k_k = p.in[14]; const float* k_a = p.in[15]; const float* r_k = p.in[16];
    float* rrec = (float*)(p.ws + OFF_RREC); float* bonus = (float*)(p.ws + OFF_BONUS); float* gate = (float*)(p.ws + OFF_GATE);
    const int tid = tidx, tl0 = cn * 64;
    __syncthreads();
    bf16_t* actb = (bf16_t*)act;
    float* lro = act + 37888 / 4;
    if (tid < 288) {
        const int i = tid, col = RW0 + 3072 + i;
        const float mui = mu[3072 + i];
        float prev = yget(yseg, carry_prev, seg, tl0 - 1, col);
#pragma unroll 1
        for (int t0 = 0; t0 < 64; t0 += 16) {
            float cv[16];
#pragma unroll
            for (int q = 0; q < 16; ++q) cv[q] = yseg[(size_t)(tl0 + t0 + q) * NINP + col];
#pragma unroll
            for (int q = 0; q < 16; ++q) { const float cur = cv[q]; const float yl = cur + (prev - cur) * mui; prev = cur;
                actb[(t0 + q) * 296 + i] = f2bf(i < 64 ? tanhf(yl) : (i < 128 ? yl : sigmoidf_(yl))); }
        }
    }
    __syncthreads();
    {
        const int r = tid & 15, qd = (tid & 63) >> 4, wv_ = tid >> 6, cB = hp * 128 + 16 * wv_ + r;
        bf16x8 bw[9];
#pragma unroll
        for (int ks = 0; ks < 9; ++ks) {
            const float* Wm = ks < 2 ? w2 : (ks < 4 ? a2 : g2); const int ib = ks < 2 ? ks * 32 : (ks < 4 ? (ks - 2) * 32 : (ks - 4) * 32);
            float t8[8];
#pragma unroll
            for (int e = 0; e < 8; ++e) t8[e] = Wm[(size_t)(ib + qd * 8 + e) * 1024 + cB];
#pragma unroll
            for (int e = 0; e < 8; ++e) bw[ks][e] = (short)f2bf(t8[e]);
        }
#pragma unroll
        for (int m = 0; m < 4; ++m) {
            f32x4 cw = (f32x4){0.f, 0.f, 0.f, 0.f}, ca = cw, cg = cw;
#pragma unroll
            for (int ks = 0; ks < 9; ++ks) { const bf16x8 af = *(const bf16x8*)(actb + (16 * m + r) * 296 + ks * 32 + qd * 8);
                if (ks < 2) cw = mfma16(af, bw[ks], cw); else if (ks < 4) ca = mfma16(af, bw[ks], ca); else cg = mfma16(af, bw[ks], cg); }
#pragma unroll
            for (int j = 0; j < 4; ++j) { const int o = (16 * m + qd * 4 + j) * 132 + 16 * wv_ + r; lro[o] = cw[j]; lro[64 * 132 + o] = ca[j]; lro[2 * 64 * 132 + o] = cg[j]; }
        }
    }
    __syncthreads();
    {
        const int tg = tid >> 7, c = hp * 128 + (tid & 127), h = c >> 6, j = c & 63, tb = tl0 + tg * 16;
        float aw[16], aa[16], ag[16];
#pragma unroll
        for (int q = 0; q < 16; ++q) { const int o = (tg * 16 + q) * 132 + (tid & 127); aw[q] = lro[o]; aa[q] = lro[64 * 132 + o]; ag[q] = lro[2 * 64 * 132 + o]; }
        const float w0c = w0[c], a0c = a0[c], kkc = k_k[c], kac = k_a[c], rkc = r_k[c], mur = mu[c], muk = mu[1024 + c], muv = mu[2048 + c];
        float rp = yget(yseg, carry_prev, seg, tb - 1, RW0 + c), kp = yget(yseg, carry_prev, seg, tb - 1, RW0 + 1024 + c), vp = yget(yseg, carry_prev, seg, tb - 1, RW0 + 2048 + c);
        float rcv[16], kcv[16], vcv[16];
#pragma unroll
        for (int q = 0; q < 16; ++q) { rcv[q] = yseg[(size_t)(tb + q) * NINP + RW0 + c]; kcv[q] = yseg[(size_t)(tb + q) * NINP + RW0 + 1024 + c]; vcv[q] = yseg[(size_t)(tb + q) * NINP + RW0 + 2048 + c]; }
#pragma unroll
        for (int q = 0; q < 16; ++q) {
            const int tl = tb + q;
            const float rc = rcv[q], kc = kcv[q], vc = vcv[q];
            const float r = rc + (rp - rc) * mur, k = kc + (kp - kc) * muk, v = vc + (vp - vc) * muv;
            const float wlog = -softplusf_(-(w0c + aw[q])) - 0.5f;
            const float logdecay = -__expf(wlog);
            const float a = sigmoidf_(a0c + aa[q]);
            const float kx = k * kkc; const float n2 = wsum(kx * kx); const float kk = kx * rsqrtf(n2 + 1e-6f);
            const float k2 = k * (1.f + (a - 1.f) * kac);
            const float bsum = wsum(r * k2 * rkc);
            float* rec = rrec + ((size_t)tl * 16 + h) * RREC + j;
            rec[0] = logdecay; rec[64] = -kk; rec[128] = kk * a; rec[192] = k2; rec[256] = r; rec[320] = v;
            bonus[(size_t)tl * 1024 + c] = bsum * v; gate[(size_t)tl * 1024 + c] = ag[q];
            rp = rc; kp = kc; vp = vc;
        }
    }
}
template <int SIGN> __device__ __forceinline__ void solve64(float (&X)[64], const float* M) {
#pragma unroll
    for (int ib = 0; ib < 16; ++ib) {
        float s0 = 0.f, s1 = 0.f, s2 = 0.f, s3 = 0.f;
#pragma unroll
        for (int jj = 0; jj < ib; ++jj) {
            const float4 m0 = *(const float4*)(M + (4 * ib + 0) * 64 + 4 * jj), m1 = *(const float4*)(M + (4 * ib + 1) * 64 + 4 * jj);
            const float4 m2 = *(const float4*)(M + (4 * ib + 2) * 64 + 4 * jj), m3 = *(const float4*)(M + (4 * ib + 3) * 64 + 4 * jj);
            s0 += m0.x * X[4 * jj] + m0.y * X[4 * jj + 1] + m0.z * X[4 * jj + 2] + m0.w * X[4 * jj + 3];
            s1 += m1.x * X[4 * jj] + m1.y * X[4 * jj + 1] + m1.z * X[4 * jj + 2] + m1.w * X[4 * jj + 3];
            s2 += m2.x * X[4 * jj] + m2.y * X[4 * jj + 1] + m2.z * X[4 * jj + 2] + m2.w * X[4 * jj + 3];
            s3 += m3.x * X[4 * jj] + m3.y * X[4 * jj + 1] + m3.z * X[4 * jj + 2] + m3.w * X[4 * jj + 3];
        }
        const float4 d1 = *(const float4*)(M + (4 * ib + 1) * 64 + 4 * ib), d2 = *(const float4*)(M + (4 * ib + 2) * 64 + 4 * ib), d3 = *(const float4*)(M + (4 * ib + 3) * 64 + 4 * ib);
        X[4 * ib] += SIGN * s0;
        X[4 * ib + 1] += SIGN * (s1 + d1.x * X[4 * ib]);
        X[4 * ib + 2] += SIGN * (s2 + d2.x * X[4 * ib] + d2.y * X[4 * ib + 1]);
        X[4 * ib + 3] += SIGN * (s3 + d3.x * X[4 * ib] + d3.y * X[4 * ib + 1] + d3.z * X[4 * ib + 2]);
    }
}
__device__ __forceinline__ void rwkv_chunk_prep(const Params& p, int seg, int cn, int head, unsigned char* shm) {
    const int tidx = ltid(), wave = tidx >> 6, l = tidx & 63;
    const int task = cn * 16 + head, tl0 = cn * 64;
    const float* rrec = (const float*)(p.ws + OFF_RREC);
    float* AAB = (float*)(shm + RC_AAB); float* PS = (float*)(shm + RC_PS); float* ATF = (float*)(shm + RC_ATF); float* RTF = (float*)(shm + RC_RTF); float* CMF = (float*)(shm + RC_CMF);
    bf16_t* ATB = (bf16_t*)(shm + RC_ATB); bf16_t* RTB = (bf16_t*)(shm + RC_RTB); bf16_t* BIB = (bf16_t*)(shm + RC_BIB); bf16_t* KIB = (bf16_t*)(shm + RC_KIB);
    bf16_t* BTT = (bf16_t*)(shm + RC_BTT); bf16_t* KTT = (bf16_t*)(shm + RC_KTT); bf16_t* VT = (bf16_t*)(shm + RC_VT);
    bf16_t* AAK = (bf16_t*)(shm + RC_AAK); bf16_t* ARB = (bf16_t*)(shm + RC_ARB); bf16_t* ARK = (bf16_t*)(shm + RC_ARK);
    __syncthreads();
    {
        const int c = l, tq = wave;
        const float* rec0 = rrec + ((size_t)(tl0 + tq * 8) * 16 + head) * RREC + c;
        float lw[8], fa[8], fb[8], fk[8], fr[8], fv[8];
#pragma unroll
        for (int q = 0; q < 8; ++q) { const float* rec = rec0 + (size_t)q * 16 * RREC; lw[q] = rec[0]; fa[q] = rec[64]; fb[q] = rec[128]; fk[q] = rec[192]; fr[q] = rec[256]; fv[q] = rec[320]; }
        float run = 0.f;
#pragma unroll
        for (int q = 0; q < 8; ++q) { run += lw[q]; lw[q] = run; }
        PS[tq * 64 + c] = run;
        __syncthreads();
        float off = 0.f, tot = 0.f;
#pragma unroll
        for (int g = 0; g < 8; ++g) { const float v = PS[g * 64 + c]; off += (g < tq) ? v : 0.f; tot += v; }
#pragma unroll
        for (int q = 0; q < 8; ++q) {
            const int t = tq * 8 + q;
            const float Lt = off + lw[q], Lm = off + (q ? lw[q - 1] : 0.f);
            const float eP = __expf(Lt), ePm = __expf(Lm), eiP = __expf(-Lt), eT = __expf(tot - Lt);
            const float At = fa[q] * ePm, Rt = fr[q] * eP;
            ATF[t * 68 + c] = At; RTF[t * 68 + c] = Rt;
            ATB[t * 72 + c] = f2bf(At); RTB[t * 72 + c] = f2bf(Rt); BIB[t * 72 + c] = f2bf(fb[q] * eiP); KIB[t * 72 + c] = f2bf(fk[q] * eiP);
            BTT[c * 72 + t] = f2bf(fb[q] * eT); KTT[c * 72 + t] = f2bf(fk[q] * eT); VT[c * 72 + t] = f2bf(fv[q]);
        }
        if (tq == 0) ((float*)(p.ws + OFF_RPC))[(size_t)task * 64 + c] = __expf(tot);
    }
    __syncthreads();
    {
        const int t2 = ltid(); const int r = t2 & 15, qd = (t2 & 63) >> 4, w2_ = t2 >> 6, prod = w2_ >> 1, mb = (w2_ & 1) * 2;
        const bf16_t* Aop = (prod < 2) ? ATB : RTB; const bf16_t* Bop = (prod & 1) ? KIB : BIB;
#pragma unroll
        for (int mi = 0; mi < 2; ++mi) {
            const int m = mb + mi;
            const bf16x8 a0 = *(const bf16x8*)(Aop + (16 * m + r) * 72 + qd * 8), a1 = *(const bf16x8*)(Aop + (16 * m + r) * 72 + 32 + qd * 8);
#pragma unroll
            for (int n = 0; n < 4; ++n) {
                const bf16x8 b0 = *(const bf16x8*)(Bop + (16 * n + r) * 72 + qd * 8), b1 = *(const bf16x8*)(Bop + (16 * n + r) * 72 + 32 + qd * 8);
                f32x4 cacc = (f32x4){0.f, 0.f, 0.f, 0.f}; cacc = mfma16(a0, b0, cacc); cacc = mfma16(a1, b1, cacc);
#pragma unroll
                for (int j = 0; j < 4; ++j) { const int t = 16 * m + qd * 4 + j, sidx = 16 * n + r;
                    const bool keep = (prod < 2) ? (t > sidx) : (t >= sidx); const float val = keep ? cacc[j] : 0.f;
                    if (prod == 0) AAB[t * 64 + sidx] = val; else if (prod == 1) AAK[t * 72 + sidx] = f2bf(val); else if (prod == 2) ARB[t * 72 + sidx] = f2bf(val); else ARK[t * 72 + sidx] = f2bf(val); }
            }
        }
    }
    __syncthreads();
    {
        const int t3 = ltid(); const int r = t3 & 15, qd = (t3 & 63) >> 4, w3 = t3 >> 6, m = w3 & 3;
        const bf16x8 a0 = *(const bf16x8*)(AAK + (16 * m + r) * 72 + qd * 8), a1 = *(const bf16x8*)(AAK + (16 * m + r) * 72 + 32 + qd * 8);
#pragma unroll
        for (int nn = 0; nn < 2; ++nn) { const int n = (w3 >> 2) * 2 + nn;
            const bf16x8 b0 = *(const bf16x8*)(VT + (16 * n + r) * 72 + qd * 8), b1 = *(const bf16x8*)(VT + (16 * n + r) * 72 + 32 + qd * 8);
            f32x4 cacc = (f32x4){0.f, 0.f, 0.f, 0.f}; cacc = mfma16(a0, b0, cacc); cacc = mfma16(a1, b1, cacc);
#pragma unroll
            for (int j = 0; j < 4; ++j) CMF[(16 * m + qd * 4 + j) * 68 + 16 * n + r] = cacc[j]; }
    }
    __syncthreads();
    float* XSg = (float*)(p.ws + OFF_XS) + (size_t)blockIdx.x * 8192;
    if (tidx < 128) {
        float X[64];
        const int c = ltid();
        const float* srcp = (c < 64) ? (CMF + c) : (ATF + (c - 64));
#pragma unroll
        for (int i = 0; i < 64; ++i) X[i] = srcp[i * 68];
        solve64<1>(X, AAB);
#pragma unroll
        for (int i = 0; i < 64; ++i) XSg[i * 128 + c] = X[i];
    }
    __syncthreads();
    {
        const int t5 = ltid(); const int r = t5 & 15, qd = (t5 & 63) >> 4, m0 = ((t5 >> 6) & 3) * 16, half = t5 >> 8;
        bf16_t* RPM = (bf16_t*)(p.ws + OFF_RPM) + (size_t)task * 4096; float* RRM = (float*)(p.ws + OFF_RRM) + (size_t)task * 4096;
        bf16_t* RQP = (bf16_t*)(p.ws + OFF_RQP) + (size_t)task * 4096; float* ROL = (float*)(p.ws + OFF_ROL) + (size_t)task * 4096;
        bf16x8 aX[2];
#pragma unroll
        for (int ks = 0; ks < 2; ++ks)
#pragma unroll
            for (int e = 0; e < 8; ++e) aX[ks][e] = (short)f2bf(XSg[(ks * 32 + qd * 8 + e) * 128 + (half ? 0 : 64) + m0 + r]);
        if (half == 0) {
#pragma unroll
            for (int n = 0; n < 4; ++n) {
                const bf16x8 b0 = *(const bf16x8*)(BTT + (16 * n + r) * 72 + qd * 8), b1 = *(const bf16x8*)(BTT + (16 * n + r) * 72 + 32 + qd * 8);
                f32x4 cacc = (f32x4){0.f, 0.f, 0.f, 0.f}; cacc = mfma16(aX[0], b0, cacc); cacc = mfma16(aX[1], b1, cacc);
                uint2 o; o.x = pack2(cacc[0], cacc[1]); o.y = pack2(cacc[2], cacc[3]); *(uint2*)(RPM + (16 * n + r) * 64 + m0 + qd * 4) = o;
            }
#pragma unroll
            for (int n = 0; n < 4; ++n) {
                const bf16x8 b0 = *(const bf16x8*)(ARB + (16 * n + r) * 72 + qd * 8), b1 = *(const bf16x8*)(ARB + (16 * n + r) * 72 + 32 + qd * 8);
                f32x4 cacc = (f32x4){0.f, 0.f, 0.f, 0.f}; cacc = mfma16(aX[0], b0, cacc); cacc = mfma16(aX[1], b1, cacc);
                const float4 rt = *(const float4*)(RTF + (16 * n + r) * 68 + m0 + qd * 4);
                uint2 o; o.x = pack2(rt.x + cacc[0], rt.y + cacc[1]); o.y = pack2(rt.z + cacc[2], rt.w + cacc[3]); *(uint2*)(RQP + (16 * n + r) * 64 + m0 + qd * 4) = o;
            }
        } else {
            bf16x8 aV[2];
#pragma unroll
            for (int ks = 0; ks < 2; ++ks) aV[ks] = *(const bf16x8*)(VT + (m0 + r) * 72 + ks * 32 + qd * 8);
#pragma unroll
            for (int n = 0; n < 4; ++n) {
                const bf16x8 b0 = *(const bf16x8*)(BTT + (16 * n + r) * 72 + qd * 8), b1 = *(const bf16x8*)(BTT + (16 * n + r) * 72 + 32 + qd * 8);
                const bf16x8 k0 = *(const bf16x8*)(KTT + (16 * n + r) * 72 + qd * 8), k1 = *(const bf16x8*)(KTT + (16 * n + r) * 72 + 32 + qd * 8);
                f32x4 cacc = (f32x4){0.f, 0.f, 0.f, 0.f}; cacc = mfma16(aX[0], b0, cacc); cacc = mfma16(aX[1], b1, cacc); cacc = mfma16(aV[0], k0, cacc); cacc = mfma16(aV[1], k1, cacc);
                *(f32x4*)(RRM + (16 * n + r) * 64 + m0 + qd * 4) = cacc;
            }
#pragma unroll
            for (int n = 0; n < 4; ++n) {
                const bf16x8 b0 = *(const bf16x8*)(ARB + (16 * n + r) * 72 + qd * 8), b1 = *(const bf16x8*)(ARB + (16 * n + r) * 72 + 32 + qd * 8);
                const bf16x8 k0 = *(const bf16x8*)(ARK + (16 * n + r) * 72 + qd * 8), k1 = *(const bf16x8*)(ARK + (16 * n + r) * 72 + 32 + qd * 8);
                f32x4 cacc = (f32x4){0.f, 0.f, 0.f, 0.f}; cacc = mfma16(aX[0], b0, cacc); cacc = mfma16(aX[1], b1, cacc); cacc = mfma16(aV[0], k0, cacc); cacc = mfma16(aV[1], k1, cacc);
                *(f32x4*)(ROL + (16 * n + r) * 64 + m0 + qd * 4) = cacc;
            }
        }
    }
}
__device__ __forceinline__ void rwkv_cscan(const Params& p, int seg, int head, unsigned char* shm, bool store_state) {
    const int tidx = ltid(), wave = tidx >> 6, l = tidx & 63, r = l & 15, qd = l >> 4, m0 = (wave & 3) * 16, n0 = (wave >> 2) * 2;
    bf16_t* ZT = (bf16_t*)shm;
    float* SR = (float*)(p.ws + OFF_SR);
    const bf16_t* RPM = (const bf16_t*)(p.ws + OFF_RPM); const float* RRM = (const float*)(p.ws + OFF_RRM); const float* RPC = (const float*)(p.ws + OFF_RPC);
    bf16_t* RZH = (bf16_t*)(p.ws + OFF_RZH);
    f32x4 acc[2];
#pragma unroll
    for (int n = 0; n < 2; ++n)
#pragma unroll
        for (int j = 0; j < 4; ++j) acc[n][j] = seg > 0 ? SR[((size_t)head * 64 + m0 + qd * 4 + j) * 64 + 16 * (n0 + n) + r] : 0.f;
#define RS_PUT(buf_, task_, wr_hist_) { _Pragma("unroll") for (int n = 0; n < 2; ++n) { uint2 o; o.x = pack2(acc[n][0], acc[n][1]); o.y = pack2(acc[n][2], acc[n][3]); \
        *(uint2*)(ZT + ((buf_) * 64 + 16 * (n0 + n) + r) * 72 + m0 + qd * 4) = o; \
        if (wr_hist_) *(uint2*)(RZH + (size_t)(task_) * 4096 + (16 * (n0 + n) + r) * 64 + m0 + qd * 4) = o; } }
    __syncthreads();
    RS_PUT(0, head, true);
    __syncthreads();
    bf16x8 aP[2]; float Rr[2][4]; float pc[4];
    { const int task = head;
#pragma unroll
      for (int ks = 0; ks < 2; ++ks) aP[ks] = *(const bf16x8*)(RPM + (size_t)task * 4096 + (m0 + r) * 64 + ks * 32 + qd * 8);
#pragma unroll
      for (int n = 0; n < 2; ++n)
#pragma unroll
          for (int j = 0; j < 4; ++j) Rr[n][j] = RRM[(size_t)task * 4096 + (m0 + qd * 4 + j) * 64 + 16 * (n0 + n) + r];
#pragma unroll
      for (int j = 0; j < 4; ++j) pc[j] = RPC[(size_t)task * 64 + m0 + qd * 4 + j]; }
    int cur = 0;
#pragma unroll 1
    for (int cn = 0; cn < SEG / 64; ++cn) {
        const int cnn = (cn + 1 < SEG / 64) ? cn + 1 : cn, ntask = cnn * 16 + head;
        bf16x8 nP[2]; float nR[2][4]; float npc[4];
#pragma unroll
        for (int ks = 0; ks < 2; ++ks) nP[ks] = *(const bf16x8*)(RPM + (size_t)ntask * 4096 + (m0 + r) * 64 + ks * 32 + qd * 8);
#pragma unroll
        for (int n = 0; n < 2; ++n)
#pragma unroll
            for (int j = 0; j < 4; ++j) nR[n][j] = RRM[(size_t)ntask * 4096 + (m0 + qd * 4 + j) * 64 + 16 * (n0 + n) + r];
#pragma unroll
        for (int j = 0; j < 4; ++j) npc[j] = RPC[(size_t)ntask * 64 + m0 + qd * 4 + j];
#pragma unroll
        for (int n = 0; n < 2; ++n) {
#pragma unroll
            for (int j = 0; j < 4; ++j) acc[n][j] = acc[n][j] * pc[j] + Rr[n][j];
#pragma unroll
            for (int ks = 0; ks < 2; ++ks) { const bf16x8 b = *(const bf16x8*)(ZT + (cur * 64 + 16 * (n0 + n) + r) * 72 + ks * 32 + qd * 8); acc[n] = mfma16(aP[ks], b, acc[n]); }
        }
        RS_PUT(cur ^ 1, ntask, (cn + 1 < SEG / 64));
        __syncthreads();
        cur ^= 1;
#pragma unroll
        for (int ks = 0; ks < 2; ++ks) aP[ks] = nP[ks];
#pragma unroll
        for (int n = 0; n < 2; ++n)
#pragma unroll
            for (int j = 0; j < 4; ++j) Rr[n][j] = nR[n][j];
#pragma unroll
        for (int j = 0; j < 4; ++j) pc[j] = npc[j];
    }
#undef RS_PUT
    if (store_state)
#pragma unroll
    for (int n = 0; n < 2; ++n)
#pragma unroll
        for (int j = 0; j < 4; ++j) SR[((size_t)head * 64 + m0 + qd * 4 + j) * 64 + 16 * (n0 + n) + r] = acc[n][j];
}
__device__ __forceinline__ void rwkv_cout(const Params& p, int seg) {
    const int tidx = ltid(), wave = tidx >> 6, l = tidx & 63, r = l & 15, qd = l >> 4, i0 = (wave & 3) * 16;
    const bf16_t* RQP = (const bf16_t*)(p.ws + OFF_RQP); const float* ROL = (const float*)(p.ws + OFF_ROL); const bf16_t* RZH = (const bf16_t*)(p.ws + OFF_RZH);
    const float* bonus = (const float*)(p.ws + OFF_BONUS); const float* gate = (const float*)(p.ws + OFF_GATE);
    const float* lnw = p.in[17]; const float* lnb = p.in[18];
    bf16_t* mixed = (bf16_t*)(p.ws + OFF_AB1);
    if (wave >= 4)
    for (int t2 = 0; t2 < 2; ++t2) {
        const int task = lbid() * 2 + t2, h = task & 15, cn = task >> 4;
        bf16x8 aQ[2];
#pragma unroll
        for (int ks = 0; ks < 2; ++ks) aQ[ks] = *(const bf16x8*)(RQP + (size_t)task * 4096 + (i0 + r) * 64 + ks * 32 + qd * 8);
        bf16x8 bz[4][2];
#pragma unroll
        for (int n = 0; n < 4; ++n)
#pragma unroll
            for (int ks = 0; ks < 2; ++ks) bz[n][ks] = *(const bf16x8*)(RZH + (size_t)task * 4096 + (16 * n + r) * 64 + ks * 32 + qd * 8);
        f32x4 acc[4];
#pragma unroll
        for (int n = 0; n < 4; ++n)
#pragma unroll
            for (int j = 0; j < 4; ++j) acc[n][j] = ROL[(size_t)task * 4096 + (i0 + qd * 4 + j) * 64 + 16 * n + r];
#pragma unroll
        for (int n = 0; n < 4; ++n)
#pragma unroll
            for (int ks = 0; ks < 2; ++ks) acc[n] = mfma16(aQ[ks], bz[n][ks], acc[n]);
#pragma unroll
        for (int j = 0; j < 4; ++j) {
            const int tl = cn * 64 + i0 + qd * 4 + j;
            const float mean = allred16((acc[0][j] + acc[1][j]) + (acc[2][j] + acc[3][j])) * (1.f / 64.f);
            float vs = 0.f;
#pragma unroll
            for (int n = 0; n < 4; ++n) { const float d = acc[n][j] - mean; vs += d * d; }
            const float rstd = rsqrtf(allred16(vs) * (1.f / 64.f) + 64e-5f);
#pragma unroll
            for (int n = 0; n < 4; ++n) { const int c = h * 64 + 16 * n + r;
                const float y = (acc[n][j] - mean) * rstd * lnw[c] + lnb[c];
                mixed[(size_t)(seg * SEG + tl) * 2048 + 1024 + c] = f2bf((y + bonus[(size_t)tl * 1024 + c]) * gate[(size_t)tl * 1024 + c]); }
        }
    }
}
__device__ __forceinline__ void gdn_prep_chunk(const Params& p, int seg, int task, unsigned char* shm) {
    const int tidx = ltid();
    const int h = task & 7, cn = task >> 3, tl0 = cn * 64, wave = tidx >> 6, l = tidx & 63;
    float* qf = (float*)(shm + GP_QF); float* kf = (float*)(shm + GP_KF); float* vf = (float*)(shm + GP_VF);
    float* Mm = (float*)(shm + GP_MM); float* Am = (float*)(shm + GP_AM); bf16_t* ktT = (bf16_t*)(shm + GP_KTT); bf16_t* Ab = (bf16_t*)(shm + GP_AB);
    float* sm = (float*)(shm + GP_SM);
    const float* yseg = (const float*)(p.ws + OFF_YSEG);
    const float* carry_prev = (const float*)(p.ws + OFF_CARRY) + (size_t)((seg + 1) & 1) * 3 * NINP;
    const float* cw = p.in[4]; const float* A_log = p.in[5]; const float* dtb = p.in[6];
    float* sz = (float*)(p.ws + OFF_SZ);
    __syncthreads();
    {
        float wq[4][2], wk[4][2], wv[4][2];
#pragma unroll
        for (int j = 0; j < 4; ++j)
#pragma unroll
            for (int e = 0; e < 2; ++e) { const int col = h * 128 + 2 * l + e; wq[j][e] = cw[j * 3072 + col]; wk[j][e] = cw[j * 3072 + 1024 + col]; wv[j][e] = cw[j * 3072 + 2048 + col]; }
        const float nA = -__expf(A_log[h]), db = dtb[h];
        float xq[11][2], xk[11][2], xv[11][2];
#pragma unroll
        for (int rr = 0; rr < 11; ++rr) {
            const int ts = tl0 + wave * 8 - 3 + rr;
            const float* rowp = (ts >= 0) ? (yseg + (size_t)ts * NINP) : (carry_prev + (size_t)(3 + ts) * NINP);
            float2 a2 = make_float2(0.f, 0.f), b2 = a2, c2 = a2;
            if (ts >= 0 || seg > 0) { a2 = *(const float2*)(rowp + h * 128 + 2 * l); b2 = *(const float2*)(rowp + 1024 + h * 128 + 2 * l); c2 = *(const float2*)(rowp + 2048 + h * 128 + 2 * l); }
            xq[rr][0] = a2.x; xq[rr][1] = a2.y; xk[rr][0] = b2.x; xk[rr][1] = b2.y; xv[rr][0] = c2.x; xv[rr][1] = c2.y;
        }
        float2 zz[8]; float adt8 = 0.f, bb8 = 0.f;
#pragma unroll
        for (int q8 = 0; q8 < 8; ++q8) zz[q8] = *(const float2*)(yseg + (size_t)(tl0 + wave * 8 + q8) * NINP + 3072 + h * 128 + 2 * l);
        if (l < 8) { adt8 = yseg[(size_t)(tl0 + wave * 8 + l) * NINP + 4096 + h]; bb8 = yseg[(size_t)(tl0 + wave * 8 + l) * NINP + 4104 + h]; }
#pragma unroll
        for (int q8 = 0; q8 < 8; ++q8) {
            const int tok = wave * 8 + q8, tl = tl0 + tok;
            float qv[2] = {0.f, 0.f}, kv[2] = {0.f, 0.f}, vv[2] = {0.f, 0.f};
#pragma unroll
            for (int j = 0; j < 4; ++j)
#pragma unroll
                for (int e = 0; e < 2; ++e) { qv[e] += wq[j][e] * xq[q8 + j][e]; kv[e] += wk[j][e] * xk[q8 + j][e]; vv[e] += wv[j][e] * xv[q8 + j][e]; }
#pragma unroll
            for (int e = 0; e < 2; ++e) { qv[e] = siluf_(qv[e]); kv[e] = siluf_(kv[e]); vv[e] = siluf_(vv[e]); }
            const float qn = wsum(qv[0] * qv[0] + qv[1] * qv[1]), kn = wsum(kv[0] * kv[0] + kv[1] * kv[1]);
            const float qs = rsqrtf(qn + 1e-6f) * 0.08838834764831845f, ks = rsqrtf(kn + 1e-6f);
            *(float2*)(qf + tok * 132 + 2 * l) = make_float2(qv[0] * qs, qv[1] * qs);
            *(float2*)(kf + tok * 132 + 2 * l) = make_float2(kv[0] * ks, kv[1] * ks);
            *(float2*)(vf + tok * 132 + 2 * l) = make_float2(vv[0], vv[1]);
            *(float2*)(sz + (size_t)tl * 1024 + h * 128 + 2 * l) = make_float2(siluf_(zz[q8].x), siluf_(zz[q8].y));
        }
        if (l < 8) { sm[wave * 8 + l] = nA * softplusf_(adt8 + db); sm[64 + wave * 8 + l] = sigmoidf_(bb8); }
    }
    __syncthreads();
    if (wave == 0) {
        float g = sm[l];
#pragma unroll
        for (int o = 1; o < 64; o <<= 1) { const float t = __shfl_up(g, o); if (l >= o) g += t; }
        const float Gl = __shfl(g, 63);
        sm[l] = g; sm[128 + l] = __expf(g); sm[192 + l] = __expf(Gl - g);
        if (l == 63) ((float*)(p.ws + OFF_EG))[task] = __expf(g);
    }
    __syncthreads();
    {
        const int t2 = ltid(); const int r = t2 & 15, qd = (t2 & 63) >> 4, w2_ = t2 >> 6, prod = w2_ >> 2, m = w2_ & 3;
        const float* Asrc = prod ? qf : kf;
        bf16x8 af[4];
#pragma unroll
        for (int ks = 0; ks < 4; ++ks) { const float4 x0 = *(const float4*)(Asrc + (16 * m + r) * 132 + ks * 32 + qd * 8), x1 = *(const float4*)(Asrc + (16 * m + r) * 132 + ks * 32 + qd * 8 + 4);
            af[ks][0] = (short)f2bf(x0.x); af[ks][1] = (short)f2bf(x0.y); af[ks][2] = (short)f2bf(x0.z); af[ks][3] = (short)f2bf(x0.w);
            af[ks][4] = (short)f2bf(x1.x); af[ks][5] = (short)f2bf(x1.y); af[ks][6] = (short)f2bf(x1.z); af[ks][7] = (short)f2bf(x1.w); }
#pragma unroll
        for (int n = 0; n < 4; ++n) {
            f32x4 cacc = (f32x4){0.f, 0.f, 0.f, 0.f};
#pragma unroll
            for (int ks = 0; ks < 4; ++ks) { const float4 x0 = *(const float4*)(kf + (16 * n + r) * 132 + ks * 32 + qd * 8), x1 = *(const float4*)(kf + (16 * n + r) * 132 + ks * 32 + qd * 8 + 4);
                bf16x8 bfr; bfr[0] = (short)f2bf(x0.x); bfr[1] = (short)f2bf(x0.y); bfr[2] = (short)f2bf(x0.z); bfr[3] = (short)f2bf(x0.w);
                bfr[4] = (short)f2bf(x1.x); bfr[5] = (short)f2bf(x1.y); bfr[6] = (short)f2bf(x1.z); bfr[7] = (short)f2bf(x1.w);
                cacc = mfma16(af[ks], bfr, cacc); }
#pragma unroll
            for (int j = 0; j < 4; ++j) { const int i = 16 * m + qd * 4 + j, jx = 16 * n + r; const float gam = (i >= jx) ? __expf(sm[i] - sm[jx]) : 0.f;
                if (prod == 0) Mm[i * 64 + jx] = (i > jx) ? sm[64 + i] * cacc[j] * gam : 0.f; else Am[i * 64 + jx] = cacc[j] * gam; }
        }
    }
    __syncthreads();
    float* UWg = (float*)(p.ws + OFF_UW) + (size_t)task * 16384;
    if (tidx < 256) {
        float X[64];
        const int c = ltid();
        {
            const float* srcp = (c < 128) ? (vf + c) : (kf + (c - 128));
#pragma unroll
            for (int i = 0; i < 64; ++i) { float sc = sm[64 + i]; if (c >= 128) sc *= sm[128 + i]; X[i] = srcp[i * 132] * sc; }
        }
        solve64<-1>(X, Mm);
#pragma unroll
        for (int i = 0; i < 64; ++i) UWg[i * 256 + c] = X[i];
    }
    else {
        const int t5 = ltid() - 256; const int d = t5 & 127, iq = t5 >> 7;
#pragma unroll 4
        for (int ii = 0; ii < 32; ii += 2) { const int i = iq * 32 + ii;
            *(unsigned*)(ktT + d * 72 + i) = pack2(kf[i * 132 + d] * sm[192 + i], kf[(i + 1) * 132 + d] * sm[192 + i + 1]); }
#pragma unroll 4
        for (int e = 0; e < 8; ++e) { const int idx = (e * 256 + t5) * 2, i = idx >> 6, j = idx & 63;
            *(unsigned*)(Ab + i * 72 + j) = pack2(Am[i * 64 + j], Am[i * 64 + j + 1]); }
#pragma unroll 4
        for (int e = 0; e < 32; ++e) { const int idx = e * 256 + t5, i = idx >> 7, dd = idx & 127; qf[i * 132 + dd] *= sm[128 + i]; }
    }
    __syncthreads();
    {
        const int t4 = ltid(); const int r = t4 & 15, qd = (t4 & 63) >> 4, m0 = (t4 >> 6) * 16;
        bf16x8 aW[2], aU[2];
#pragma unroll
        for (int ks = 0; ks < 2; ++ks)
#pragma unroll
            for (int e = 0; e < 8; ++e) { const float* rp = UWg + (ks * 32 + qd * 8 + e) * 256 + m0 + r; aU[ks][e] = (short)f2bf(rp[0]); aW[ks][e] = (short)f2bf(rp[128]); }
        bf16_t* PMg = (bf16_t*)(p.ws + OFF_PM) + (size_t)task * 16384; float* RNg = (float*)(p.ws + OFF_RN) + (size_t)task * 16384;
        bf16_t* QPg = (bf16_t*)(p.ws + OFF_QP) + (size_t)task * 8192; float* OLg = (float*)(p.ws + OFF_OL) + (size_t)task * 8192;
#pragma unroll 2
        for (int n = 0; n < 8; ++n) {
            const bf16x8 b0 = *(const bf16x8*)(ktT + (16 * n + r) * 72 + qd * 8), b1 = *(const bf16x8*)(ktT + (16 * n + r) * 72 + 32 + qd * 8);
            f32x4 cp = (f32x4){0.f, 0.f, 0.f, 0.f}, cr = (f32x4){0.f, 0.f, 0.f, 0.f};
            cp = mfma16(aW[0], b0, cp); cp = mfma16(aW[1], b1, cp); cr = mfma16(aU[0], b0, cr); cr = mfma16(aU[1], b1, cr);
            const int d = 16 * n + r, c = m0 + qd * 4;
            uint2 o; o.x = pack2(-cp[0], -cp[1]); o.y = pack2(-cp[2], -cp[3]); *(uint2*)(PMg + d * 128 + c) = o;
            *(f32x4*)(RNg + d * 128 + c) = cr;
        }
#pragma unroll 2
        for (int n = 0; n < 4; ++n) {
            const bf16x8 b0 = *(const bf16x8*)(Ab + (16 * n + r) * 72 + qd * 8), b1 = *(const bf16x8*)(Ab + (16 * n + r) * 72 + 32 + qd * 8);
            f32x4 cq = (f32x4){0.f, 0.f, 0.f, 0.f}, co = (f32x4){0.f, 0.f, 0.f, 0.f};
            cq = mfma16(aW[0], b0, cq); cq = mfma16(aW[1], b1, cq); co = mfma16(aU[0], b0, co); co = mfma16(aU[1], b1, co);
            const int i = 16 * n + r, dm = m0 + qd * 4;
            const float4 qv = *(const float4*)(qf + i * 132 + dm);
            uint2 o; o.x = pack2(qv.x - cq[0], qv.y - cq[1]); o.y = pack2(qv.z - cq[2], qv.w - cq[3]); *(uint2*)(QPg + i * 128 + dm) = o;
            *(f32x4*)(OLg + i * 128 + dm) = co;
        }
    }
}

__device__ __forceinline__ void rwkv_scan(const Params& p, int seg, int hb, float* lds, bool store_state) {
    const int tidx = ltid();
    const float* rrec = (const float*)(p.ws + OFF_RREC); float* orw = (float*)(p.ws + OFF_ORW); float* SR = (float*)(p.ws + OFF_SR);
    const int tid = tidx, wave = tid >> 6, lane = tid & 63, head = hb >> 2, rq = hb & 3;
    const int row = rq * 16 + (wave & 3) * 4 + (lane >> 4), j = lane & 15;
    constexpr int TS = 32, TF = TS * RREC;
    f32x2 S01 = (f32x2){0.f, 0.f}, S23 = (f32x2){0.f, 0.f};
    if (wave < 4 && seg > 0) { const float4 S = *(const float4*)(SR + ((size_t)head * 64 + row) * 64 + 4 * j); S01 = (f32x2){S.x, S.y}; S23 = (f32x2){S.z, S.w}; }
    float4 rg0, rg1, rg2, rg3, rg4, rg5;
#define RW_GL(R, i, tile_) { const int e = tid + (i) * 512, st = e / 96, off = e % 96; R = *(const float4*)(rrec + ((size_t)((tile_) * TS + st) * 16 + head) * RREC + off * 4); }
#define RW_GLOAD(tile_) { RW_GL(rg0, 0, tile_) RW_GL(rg1, 1, tile_) RW_GL(rg2, 2, tile_) RW_GL(rg3, 3, tile_) RW_GL(rg4, 4, tile_) RW_GL(rg5, 5, tile_) }
#define RW_LS(R, i, buf_) { *(float4*)(lds + (buf_) * TF + (tid + (i) * 512) * 4) = R; }
#define RW_LSTORE(buf_) { RW_LS(rg0, 0, buf_) RW_LS(rg1, 1, buf_) RW_LS(rg2, 2, buf_) RW_LS(rg3, 3, buf_) RW_LS(rg4, 4, buf_) RW_LS(rg5, 5, buf_) }
    __syncthreads();
    RW_GLOAD(0); RW_LSTORE(0); __syncthreads();
    int cur = 0;
    for (int tile = 0; tile < SEG / TS; ++tile) {
        const int ntile = (tile + 1 < SEG / TS) ? tile + 1 : tile;
        RW_GLOAD(ntile);
        if (wave < 4) {
            const float* base = lds + cur * TF + 4 * j;
            const float* vbase = lds + cur * TF + 320 + row;
            f32x4 w4 = *(const f32x4*)(base), a4 = *(const f32x4*)(base + 64), b4 = *(const f32x4*)(base + 128), k4 = *(const f32x4*)(base + 192), r4 = *(const f32x4*)(base + 256);
            float vv = vbase[0];
            float obuf = 0.f;
#pragma unroll 16
            for (int st = 0; st < TS; ++st) {
                const float* nb = base + (st + 1) * RREC;
                const f32x4 nw4 = *(const f32x4*)(nb), na4 = *(const f32x4*)(nb + 64), nb4 = *(const f32x4*)(nb + 128), nk4 = *(const f32x4*)(nb + 192), nr4 = *(const f32x4*)(nb + 256);
                const float nvv = vbase[(st + 1) * RREC];
                const f32x2 a01 = __builtin_shufflevector(a4, a4, 0, 1), a23 = __builtin_shufflevector(a4, a4, 2, 3);
                f32x2 t = S01 * a01; t = S23 * a23 + t;
                const float sa = allred16(t[0] + t[1]);
                const f32x2 sa2 = (f32x2){sa, sa}, v2 = (f32x2){vv, vv};
                const f32x2 b01 = __builtin_shufflevector(b4, b4, 0, 1), b23 = __builtin_shufflevector(b4, b4, 2, 3);
                const f32x2 k01 = __builtin_shufflevector(k4, k4, 0, 1), k23 = __builtin_shufflevector(k4, k4, 2, 3);
                const f32x2 w01 = __builtin_shufflevector(w4, w4, 0, 1), w23 = __builtin_shufflevector(w4, w4, 2, 3);
                f32x2 u01 = v2 * k01; u01 = sa2 * b01 + u01; S01 = S01 * w01 + u01;
                f32x2 u23 = v2 * k23; u23 = sa2 * b23 + u23; S23 = S23 * w23 + u23;
                const f32x2 r01 = __builtin_shufflevector(r4, r4, 0, 1), r23 = __builtin_shufflevector(r4, r4, 2, 3);
                f32x2 q = S01 * r01; q = S23 * r23 + q;
                const float o = allred16(q[0] + q[1]);
                obuf = ((st & 15) == j) ? o : obuf;
                if ((st & 15) == 15) orw[(size_t)(tile * TS + (st & ~15) + j) * 1024 + head * 64 + row] = obuf;
                w4 = nw4; a4 = na4; b4 = nb4; k4 = nk4; r4 = nr4; vv = nvv;
            }
        }
        RW_LSTORE(cur ^ 1);
        __syncthreads();
        cur ^= 1;
    }
#undef RW_GL
#undef RW_GLOAD
#undef RW_LS
#undef RW_LSTORE
    if (wave < 4 && store_state) *(float4*)(SR + ((size_t)head * 64 + row) * 64 + 4 * j) = make_float4(S01[0], S01[1], S23[0], S23[1]);
}
__device__ __forceinline__ void gdn_scan(const Params& p, int seg, int gb, unsigned char* shm, bool store_state) {
    const int tidx = ltid(), wave = tidx >> 6, l = tidx & 63, r = l & 15, qd = l >> 4;
    const int head = gb >> 2, c0 = (gb & 3) * 32, m0 = wave * 16;
    bf16_t* ST = (bf16_t*)shm;
    float* SG = (float*)(p.ws + OFF_SG);
    const bf16_t* PM = (const bf16_t*)(p.ws + OFF_PM); const float* RN = (const float*)(p.ws + OFF_RN); const float* EG = (const float*)(p.ws + OFF_EG);
    bf16_t* SH = (bf16_t*)(p.ws + OFF_SH);
    f32x4 acc[2];
#pragma unroll
    for (int n = 0; n < 2; ++n)
#pragma unroll
        for (int j = 0; j < 4; ++j) acc[n][j] = seg > 0 ? SG[((size_t)head * 128 + m0 + qd * 4 + j) * 128 + c0 + 16 * n + r] : 0.f;
#define GS_PUT(buf_, task_, wr_hist_) { _Pragma("unroll") for (int n = 0; n < 2; ++n) { uint2 o; o.x = pack2(acc[n][0], acc[n][1]); o.y = pack2(acc[n][2], acc[n][3]); \
        *(uint2*)(ST + ((buf_) * 32 + 16 * n + r) * 136 + m0 + qd * 4) = o; \
        if (wr_hist_) *(uint2*)(SH + (size_t)(task_) * 16384 + (c0 + 16 * n + r) * 128 + m0 + qd * 4) = o; } }
    __syncthreads();
    GS_PUT(0, head, true);
    __syncthreads();
    bf16x8 aP[4]; float Rr[2][4]; float eg;
    { const int task = head;
#pragma unroll
      for (int ks = 0; ks < 4; ++ks) aP[ks] = *(const bf16x8*)(PM + (size_t)task * 16384 + (m0 + r) * 128 + ks * 32 + qd * 8);
#pragma unroll
      for (int n = 0; n < 2; ++n)
#pragma unroll
          for (int j = 0; j < 4; ++j) Rr[n][j] = RN[(size_t)task * 16384 + (m0 + qd * 4 + j) * 128 + c0 + 16 * n + r];
      eg = EG[task]; }
    int cur = 0;
#pragma unroll 1
    for (int cn = 0; cn < SEG / 64; ++cn) {
        const int cnn = (cn + 1 < SEG / 64) ? cn + 1 : cn, ntask = cnn * 8 + head;
        bf16x8 nP[4]; float nR[2][4];
#pragma unroll
        for (int ks = 0; ks < 4; ++ks) nP[ks] = *(const bf16x8*)(PM + (size_t)ntask * 16384 + (m0 + r) * 128 + ks * 32 + qd * 8);
#pragma unroll
        for (int n = 0; n < 2; ++n)
#pragma unroll
            for (int j = 0; j < 4; ++j) nR[n][j] = RN[(size_t)ntask * 16384 + (m0 + qd * 4 + j) * 128 + c0 + 16 * n + r];
        const float neg = EG[ntask];
#pragma unroll
        for (int n = 0; n < 2; ++n) {
#pragma unroll
            for (int j = 0; j < 4; ++j) acc[n][j] = acc[n][j] * eg + Rr[n][j];
#pragma unroll
            for (int ks = 0; ks < 4; ++ks) { const bf16x8 b = *(const bf16x8*)(ST + (cur * 32 + 16 * n + r) * 136 + ks * 32 + qd * 8); acc[n] = mfma16(aP[ks], b, acc[n]); }
        }
        GS_PUT(cur ^ 1, ntask, (cn + 1 < SEG / 64));
        __syncthreads();
        cur ^= 1;
#pragma unroll
        for (int ks = 0; ks < 4; ++ks) aP[ks] = nP[ks];
#pragma unroll
        for (int n = 0; n < 2; ++n)
#pragma unroll
            for (int j = 0; j < 4; ++j) Rr[n][j] = nR[n][j];
        eg = neg;
    }
#undef GS_PUT
    if (store_state)
#pragma unroll
    for (int n = 0; n < 2; ++n)
#pragma unroll
        for (int j = 0; j < 4; ++j) SG[((size_t)head * 128 + m0 + qd * 4 + j) * 128 + c0 + 16 * n + r] = acc[n][j];
}
__device__ __forceinline__ void gdn_out(const Params& p, int seg) {
    const int tidx = ltid(), wave = tidx >> 6, l = tidx & 63, r = l & 15, qd = l >> 4, i0 = (wave & 3) * 16;
    const bf16_t* QP = (const bf16_t*)(p.ws + OFF_QP); const float* OL = (const float*)(p.ws + OFF_OL); const bf16_t* SH = (const bf16_t*)(p.ws + OFF_SH);
    const float* sz = (const float*)(p.ws + OFF_SZ); const float* gnw = p.in[7];
    bf16_t* mixed = (bf16_t*)(p.ws + OFF_AB1);
    if (wave < 4) {
        const int task = lbid(), h = task & 7, cn = task >> 3;
        bf16x8 aQ[4];
#pragma unroll
        for (int ks = 0; ks < 4; ++ks) aQ[ks] = *(const bf16x8*)(QP + (size_t)task * 8192 + (i0 + r) * 128 + ks * 32 + qd * 8);
        f32x4 acc[8];
#pragma unroll
        for (int n = 0; n < 8; ++n)
#pragma unroll
            for (int j = 0; j < 4; ++j) acc[n][j] = OL[(size_t)task * 8192 + (i0 + qd * 4 + j) * 128 + 16 * n + r];
#pragma unroll
        for (int n = 0; n < 8; ++n)
#pragma unroll
            for (int ks = 0; ks < 4; ++ks) { const bf16x8 b = *(const bf16x8*)(SH + (size_t)task * 16384 + (16 * n + r) * 128 + ks * 32 + qd * 8); acc[n] = mfma16(aQ[ks], b, acc[n]); }
#pragma unroll
        for (int j = 0; j < 4; ++j) {
            float ss = 0.f;
#pragma unroll
            for (int n = 0; n < 8; ++n) ss += acc[n][j] * acc[n][j];
            ss = allred16(ss);
            const float rs = rsqrtf(ss * (1.f / 128.f) + 1e-6f);
            const int tl = cn * 64 + i0 + qd * 4 + j;
#pragma unroll
            for (int n = 0; n < 8; ++n) { const int c = 16 * n + r;
                mixed[(size_t)(seg * SEG + tl) * 2048 + h * 128 + c] = f2bf(acc[n][j] * rs * gnw[c] * sz[(size_t)tl * 1024 + h * 128 + c]); }
        }
    }
}

__device__ __forceinline__ void mixer_post(const Params& p, int seg) {
    const int tidx = ltid();
    const float* orw = (const float*)(p.ws + OFF_ORW);
    const float* sz = (const float*)(p.ws + OFF_SZ); const float* bonus = (const float*)(p.ws + OFF_BONUS); const float* gate = (const float*)(p.ws + OFF_GATE);
    const float* lnw = p.in[17]; const float* lnb = p.in[18];
    bf16_t* mixed = (bf16_t*)(p.ws + OFF_AB1);
    const int gw = blockIdx.x * 8 + (tidx >> 6), nw = gridDim.x * 8, l = tidx & 63;
    for (int tl = gw; tl < SEG; tl += nw) {
        bf16_t* mrow = mixed + (size_t)(seg * SEG + tl) * 2048;
#pragma unroll 2
        for (int h = 0; h < 16; ++h) {
            const int c = h * 64 + l;
            const float o = orw[(size_t)tl * 1024 + c];
            const float mean = wsum(o) * (1.f / 64.f); const float d = o - mean; const float var = wsum(d * d) * (1.f / 64.f);
            const float y = d * rsqrtf(var + 64e-5f) * lnw[c] + lnb[c];
            mrow[1024 + c] = f2bf((y + bonus[(size_t)tl * 1024 + c]) * gate[(size_t)tl * 1024 + c]);
        }
    }
}

#ifndef GM
#define GM 0xFFFFFFFFu
#endif
#ifndef REP_P0
#define REP_P0 1
#endif
#ifndef REP_PREP
#define REP_PREP 1
#endif
#ifndef REP_INPROJ
#define REP_INPROJ 1
#endif
#ifndef REP_UP
#define REP_UP 1
#endif
#ifndef REP_WOUT
#define REP_WOUT 1
#endif
#ifndef REP_RT
#define REP_RT 1
#endif
#ifndef REP_RC
#define REP_RC 1
#endif
#ifndef REP_GP
#define REP_GP 1
#endif
#ifndef REP_SCAN
#define REP_SCAN 1
#endif
#ifndef REP_POST
#define REP_POST 1
#endif
constexpr unsigned PH_ALL = 0x1FFFu;
template <unsigned PH> __global__ void __launch_bounds__(512, 2) mega(Params p, int seg_lo, int seg_hi) {
    extern __shared__ __attribute__((aligned(16))) unsigned char shm[];
    LAS unsigned char* lds_ = (LAS unsigned char*)shm;
#define SYNC0() do { if constexpr (PH == PH_ALL) cg::this_grid().sync(); } while (0)
#define SYNC() do { if constexpr (PH == PH_ALL) xcd_barrier(xb); } while (0)
    XcdBarrier xb; xb.bar = nullptr; xb.x = 0; xb.st = (volatile LAS unsigned*)(lds_ + (LDS_BYTES - 16));
    if constexpr (PH == PH_ALL) {
        if (threadIdx.x == 0) { xb.st[0] = 0u; xb.st[1] = 0u; }
        __syncthreads();
        xb = xcd_barrier_post((unsigned*)(p.ws + OFF_BAR), (volatile LAS unsigned*)(lds_ + (LDS_BYTES - 16)));
    }
    LAS unsigned char* lds = (LAS unsigned char*)shm;
    float* ldsf = (float*)shm;
#define WSB (p.ws)
#define WIN ((bf16_t*)(WSB + OFF_WIN))
#define WOUT ((bf16_t*)(WSB + OFF_WOUT))
#define WQ ((bf16_t*)(WSB + OFF_WQ))
#define WK ((bf16_t*)(WSB + OFF_WK))
#define WV ((bf16_t*)(WSB + OFF_WV))
#define WO ((bf16_t*)(WSB + OFF_WO))
#define WUP ((bf16_t*)(WSB + OFF_WUP))
#define WDN ((bf16_t*)(WSB + OFF_WDN))
#define MN ((bf16_t*)(WSB + OFF_MN))
#define KX ((bf16_t*)(WSB + OFF_KX))
#define VT ((bf16_t*)(WSB + OFF_VT))
#define RSTDX ((float*)(WSB + OFF_RSTDX))
#define SSQ1 ((float*)(WSB + OFF_SSQ1))
#define SSQ2 ((float*)(WSB + OFF_SSQ2))
#define PROW ((float*)(WSB + OFF_PROW))
#define AB0 ((bf16_t*)(WSB + OFF_AB0))
#define AB1 ((bf16_t*)(WSB + OFF_AB1))
#define UB ((bf16_t*)(WSB + OFF_U))
#define YSEG ((float*)(WSB + OFF_YSEG))

    if constexpr (PH & 1u) for (int rep_ = 0; rep_ < REP_P0; ++rep_) {
    convT(p.in[3], WIN, p.in[2], D, NIN, NINP, ldsf);
    convT(p.in[23], WK, nullptr, D, D, D, ldsf);
    convT(p.in[24], WV, nullptr, D, D, D, ldsf);
    rows_to_bf16(p.in[0], AB0, RSTDX, nullptr, T);
    rows_to_bf16(p.in[1], MN, nullptr, p.in[21], 256);
    }
    SYNC0();

    if constexpr (PH & 0xEu)
    for (int seg = seg_lo; seg < seg_hi; ++seg) {
        const int bid = lbid();
        if (seg >= 0) {
            if constexpr (PH & 2u) { if (seg > 0) for (int rep_ = 0; rep_ < REP_POST; ++rep_) { gdn_out(p, seg - 1); rwkv_cout(p, seg - 1); } }
            if (seg == NSEG) { SYNC(); break; }
            if constexpr (PH & 4u) for (int rep_ = 0; rep_ < REP_PREP; ++rep_) {
                for (int r2_ = 0; r2_ < REP_RT; ++r2_) rwkv_prep_tile(p, seg, bid >> 3, bid & 7, ldsf);
                __syncthreads();
                for (int r2_ = 0; r2_ < REP_RC; ++r2_) { rwkv_chunk_prep(p, seg, bid >> 3, (bid & 7) * 2, shm); rwkv_chunk_prep(p, seg, bid >> 3, (bid & 7) * 2 + 1, shm); }
                for (int r2_ = 0; r2_ < REP_GP; ++r2_) gdn_prep_chunk(p, seg, bid, shm);
                if (bid == 255) {
                    float* carry = (float*)(WSB + OFF_CARRY) + (size_t)(seg & 1) * 3 * NINP;
                    for (int i = ltid(); i < 3 * NINP; i += 512) carry[i] = YSEG[(size_t)(SEG - 3) * NINP + i];
                }
            }
            SYNC();
        }
        if constexpr (PH & 8u) for (int rep_ = 0; rep_ < REP_SCAN; ++rep_) {
            if (seg >= 0) {
                if (bid < 32) gdn_scan(p, seg, bid, shm, rep_ == REP_SCAN - 1);
                if (bid >= 32 && bid < 48) rwkv_cscan(p, seg, bid - 32, shm, rep_ == REP_SCAN - 1);
            }
            if ((seg < 0 || bid >= 48) && rep_ == 0) {
                const int ob = seg < 0 ? (int)bid : (int)bid - 48, on = seg < 0 ? (int)gridDim.x : (int)gridDim.x - 48;
                if (seg + 1 < NSEG) { EpiY e; e.Y = YSEG; e.ldc = NINP; e.rstd = RSTDX + (seg + 1) * SEG;
                    for (int r3_ = 0; r3_ < REP_INPROJ; ++r3_) run_gemm(lds, AB0 + (size_t)(seg + 1) * SEG * D, WIN, D, D, D, SEG / 256, NINP / 256, 1, 0, 0, e, 0, on, ob); }
                __syncthreads();
                if (seg >= 0 && seg < 7) {
                    const int wi = seg == 0 ? 19 : seg == 1 ? 22 : seg == 2 ? 25 : seg <= 4 ? 27 : 28;
                    const size_t wo_ = seg == 0 ? OFF_WOUT : seg == 1 ? OFF_WQ : seg == 2 ? OFF_WO : seg <= 4 ? OFF_WUP : OFF_WDN;
                    const float* cg = seg == 1 ? p.in[20] : (seg == 3 || seg == 4) ? p.in[26] : nullptr;
                    const int cK = seg >= 5 ? DFF : D, cN = (seg == 3 || seg == 4) ? DFF : D;
                    const int ct0 = (seg == 4 || seg == 6) ? 2048 : 0, ct1 = (seg == 3 || seg == 5) ? 2048 : (1 << 30);
                    if (ob >= 32) convT(p.in[wi], (bf16_t*)(WSB + wo_), cg, cK, cN, cN, ldsf, ob - 32, on - 32, ct0, ct1);
                }
            }
        }
        if (seg < 0) {
            if constexpr (PH & 8u) {
                { EpiBf e; e.O = KX; e.ldc = D; e.ssq = nullptr; e.cache = nullptr; run_gemm(lds, MN, WK, D, D, D, 1, 8, 1, 0, 0, e, 16); }
                { EpiBf e; e.O = VT; e.ldc = 256; e.ssq = nullptr; e.cache = nullptr; run_gemm(lds, WV, MN, D, D, D, 8, 1, 1, 0, 0, e, 8); }
            }
        }
        SYNC();
    }
    if constexpr (PH & 32u) { EpiRes<false, true> e; e.Rb = AB0; e.H = nullptr; e.HB = AB0; e.ssq = SSQ1; for (int rw_ = 0; rw_ < REP_WOUT; ++rw_) run_gemm(lds, AB1, WOUT, D, D, D, T / 256, 8, 1, 0, 0, e, 0); }
    SYNC();
    if constexpr (PH & 64u) { EpiBf e; e.O = AB1; e.ldc = D; e.ssq = SSQ1; e.cache = (LAS float*)(lds + 131072); e.cache[ltid() * 12] = __int_as_float(-1); if (GM & (1u << 4)) run_gemm(lds, AB0, WQ, D, D, D, T / 256, 8, 1, 0, 0, e, 0); }
    SYNC();
    if constexpr (PH & 128u) { EpiScore e; e.P = (bf16_t*)p.out; e.prow = PROW; e.scale = 0.044194173824159216f; if (GM & (1u << 5)) run_gemm(lds, AB1, KX, D, D, 512, T / 256, 1, 4, 512, 512, e, 0); }
    SYNC();
    if constexpr (PH & 256u) { EpiPV e; e.O = AB1; e.prow = PROW; if (GM & (1u << 6)) run_gemm(lds, (const bf16_t*)p.out, VT, 1024, 256, 256, T / 256, 2, 4, 256, (size_t)512 * 256, e, 0); }
    SYNC();
    if constexpr (PH & 512u) { EpiRes<false, true> e; e.Rb = AB0; e.H = nullptr; e.HB = AB0; e.ssq = SSQ2; if (GM & (1u << 7)) run_gemm(lds, AB1, WO, D, D, D, T / 256, 8, 1, 0, 0, e, 0); }
    SYNC();
    if constexpr (PH & 1024u) { EpiUp e; e.O = UB; e.ldc = DFF; e.ssq = SSQ2; e.cache = (LAS float*)(lds + 131072); e.cache[ltid() * 12] = __int_as_float(-1); for (int rep_ = 0; rep_ < REP_UP; ++rep_) run_gemm(lds, AB0, WUP, D, D, D, T / 256, DFF / 256, 1, 0, 0, e, 0); }
    SYNC();
    if constexpr (PH & 2048u) { EpiRes<false, true> e; e.Rb = AB0; e.H = nullptr; e.HB = AB0; e.ssq = SSQ1; if (GM & (1u << 9)) run_gemm(lds, UB, WDN, DFF, DFF, DFF, T / 256, 8, 1, 0, 0, e, 0); }
    SYNC();
    if constexpr (PH & 4096u) {
        const float* gain = p.in[29];
        const bf16_t* h3 = AB0; const float* ssq = SSQ1;
        const int tidx = ltid(); const int gw = blockIdx.x * 8 + (tidx >> 6), nw = gridDim.x * 8, lane = tidx & 63;
        float4 g0[4], g1[4];
#pragma unroll
        for (int i = 0; i < 4; ++i) { g0[i] = ((const float4*)gain)[(i * 64 + lane) * 2]; g1[i] = ((const float4*)gain)[(i * 64 + lane) * 2 + 1]; }
        for (int ra = gw; ra < T; ra += 2 * nw) {
            const int rb = ra + nw;
            const uint4* ha = (const uint4*)(h3 + (size_t)ra * 2048); const uint4* hb = (const uint4*)(h3 + (size_t)rb * 2048);
            uint4 va[4], vb[4];
#pragma unroll
            for (int i = 0; i < 4; ++i) { const u32x4 a = __builtin_nontemporal_load((const u32x4*)ha + i * 64 + lane), b = __builtin_nontemporal_load((const u32x4*)hb + i * 64 + lane);
                va[i] = make_uint4(a[0], a[1], a[2], a[3]); vb[i] = make_uint4(b[0], b[1], b[2], b[3]); }
            float sa = (lane < 32) ? ssq[(size_t)ra * 32 + lane] : 0.f, sb = (lane < 32) ? ssq[(size_t)rb * 32 + lane] : 0.f;
            sa = wsum(sa); sb = wsum(sb);
            const float rsa = rsqrtf(sa * (1.f / 2048.f) + 1e-6f), rsb = rsqrtf(sb * (1.f / 2048.f) + 1e-6f);
#pragma unroll
            for (int q = 0; q < 2; ++q) {
                const float rs = q ? rsb : rsa; float4* pr = (float4*)(p.out + (size_t)(q ? rb : ra) * 2048);
#pragma unroll
                for (int i = 0; i < 4; ++i) { const uint4 hv = q ? vb[i] : va[i];
                    float4 o0, o1;
                    o0.x = __uint_as_float(hv.x << 16) * rs * g0[i].x; o0.y = __uint_as_float(hv.x & 0xFFFF0000u) * rs * g0[i].y; o0.z = __uint_as_float(hv.y << 16) * rs * g0[i].z; o0.w = __uint_as_float(hv.y & 0xFFFF0000u) * rs * g0[i].w;
                    o1.x = __uint_as_float(hv.z << 16) * rs * g1[i].x; o1.y = __uint_as_float(hv.z & 0xFFFF0000u) * rs * g1[i].y; o1.z = __uint_as_float(hv.w << 16) * rs * g1[i].z; o1.w = __uint_as_float(hv.w & 0xFFFF0000u) * rs * g1[i].w;
                    __builtin_nontemporal_store((f32x4){o0.x, o0.y, o0.z, o0.w}, (f32x4*)pr + (i * 64 + lane) * 2); __builtin_nontemporal_store((f32x4){o1.x, o1.y, o1.z, o1.w}, (f32x4*)pr + (i * 64 + lane) * 2 + 1); }
            }
        }
    }
}

extern "C" void kernel_launch(void* const* d_in, const int* in_sizes, int n_in, void* d_out, int out_size, void* d_ws, size_t ws_size, hipStream_t stream) {
    Params p{};
    for (int i = 0; i < 30; ++i) p.in[i] = (const float*)d_in[i];
    p.out = (float*)d_out; p.ws = (unsigned char*)d_ws;
#ifdef ONE_LAUNCH
    static int grid_blocks = 0;
    if (!grid_blocks) {
        (void)hipFuncSetAttribute((const void*)mega<PH_ALL>, hipFuncAttributeMaxDynamicSharedMemorySize, LDS_BYTES);
        int dev = 0, cus = 0, per_cu = 0;
        (void)hipGetDevice(&dev);
        (void)hipDeviceGetAttribute(&cus, hipDeviceAttributeMultiprocessorCount, dev);
        (void)hipOccupancyMaxActiveBlocksPerMultiprocessor(&per_cu, mega<PH_ALL>, 512, LDS_BYTES);
        grid_blocks = (cus * per_cu >= 256) ? 256 : cus * per_cu;
    }
    (void)hipMemsetAsync((unsigned char*)d_ws + OFF_BAR, 0, XCD_BAR_WORDS * 4, stream);
    int lo = -1, hi = NSEG + 1;
    void* args[] = {&p, &lo, &hi};
    hipError_t e = hipLaunchCooperativeKernel((void*)mega<PH_ALL>, dim3(grid_blocks), dim3(512), args, LDS_BYTES, stream);
    if (e != hipSuccess) fprintf(stderr, "cooperative launch failed: %s (grid %d)\n", hipGetErrorString(e), grid_blocks);
#else
    static int init = 0;
#define SETA(PHV) (void)hipFuncSetAttribute((const void*)mega<PHV>, hipFuncAttributeMaxDynamicSharedMemorySize, LDS_BYTES)
    if (!init) { init = 1; SETA(1u); SETA(2u); SETA(4u); SETA(8u); SETA(32u); SETA(64u); SETA(128u); SETA(256u); SETA(512u); SETA(1024u); SETA(2048u); SETA(4096u); }
#define L(PHV, lo, hi) mega<PHV><<<256, 512, LDS_BYTES, stream>>>(p, lo, hi)
    L(1u, 0, 0);
    L(8u, -1, 0);
    for (int s = 0; s < NSEG; ++s) { L(2u, s, s + 1); L(4u, s, s + 1); L(8u, s, s + 1); }
    L(2u, NSEG, NSEG + 1); L(32u, 0, 0); L(64u, 0, 0); L(128u, 0, 0); L(256u, 0, 0); L(512u, 0, 0); L(1024u, 0, 0); L(2048u, 0, 0); L(4096u, 0, 0);
#endif
}
```

```cpp
#include <hip/hip_runtime.h>
#ifndef MULTI_LAUNCH
#define ONE_LAUNCH 1
#endif
#include <hip/hip_cooperative_groups.h>
#include <cstdio>
namespace cg = cooperative_groups;

#define LAS __attribute__((address_space(3)))
typedef unsigned short bf16_t;
typedef short bf16x8 __attribute__((ext_vector_type(8)));
typedef float f32x4 __attribute__((ext_vector_type(4)));
typedef float f32x2 __attribute__((ext_vector_type(2)));
typedef unsigned u32x4 __attribute__((ext_vector_type(4)));

constexpr int T = 16384, D = 2048, NIN = 7472, NINP = 7680, DFF = 8192;
constexpr int GDN_COLS = 4112, RW0 = 4112;
constexpr int SEG = 2048, NSEG = 8;
constexpr int RREC = 384, GREC = 388;

constexpr size_t al(size_t x) { return (x + 255) & ~(size_t)255; }
constexpr size_t OFF_WIN = 0;
constexpr size_t OFF_WOUT = OFF_WIN + (size_t)NINP * D * 2;
constexpr size_t OFF_WQ = OFF_WOUT + (size_t)D * D * 2;
constexpr size_t OFF_WK = OFF_WQ + (size_t)D * D * 2;
constexpr size_t OFF_WV = OFF_WK + (size_t)D * D * 2;
constexpr size_t OFF_WO = OFF_WV + (size_t)D * D * 2;
constexpr size_t OFF_WUP = OFF_WO + (size_t)D * D * 2;
constexpr size_t OFF_WDN = OFF_WUP + (size_t)DFF * D * 2;
constexpr size_t OFF_MN = OFF_WDN + (size_t)DFF * D * 2;
constexpr size_t OFF_KX = OFF_MN + (size_t)256 * D * 2;
constexpr size_t OFF_VT = OFF_KX + (size_t)256 * D * 2;
constexpr size_t OFF_RSTDX = OFF_VT + (size_t)256 * D * 2;
constexpr size_t OFF_SSQ1 = OFF_RSTDX + (size_t)T * 4;
constexpr size_t OFF_SSQ2 = OFF_SSQ1 + (size_t)T * 32 * 4;
constexpr size_t OFF_PROW = OFF_SSQ2 + (size_t)T * 32 * 4;
constexpr size_t OFF_CARRY = OFF_PROW + (size_t)T * 16 * 4;
constexpr size_t OFF_SG = OFF_CARRY + al((size_t)2 * 3 * NINP * 4);
constexpr size_t OFF_SR = OFF_SG + (size_t)8 * 128 * 128 * 4;
constexpr size_t OFF_AB0 = OFF_SR + (size_t)16 * 64 * 64 * 4;
constexpr size_t OFF_AB1 = OFF_AB0 + (size_t)T * D * 2;
constexpr size_t OFF_BIG = OFF_AB1 + (size_t)T * D * 2;
constexpr size_t OFF_YSEG = OFF_BIG;
constexpr size_t OFF_RREC = OFF_YSEG + (size_t)SEG * NINP * 4;
constexpr size_t OFF_GREC = OFF_RREC + (size_t)SEG * 16 * RREC * 4;
constexpr int NTASK = (SEG / 64) * 8;
constexpr size_t OFF_PM = OFF_GREC;
constexpr size_t OFF_RN = OFF_PM + (size_t)NTASK * 16384 * 2;
constexpr size_t OFF_QP = OFF_RN + (size_t)NTASK * 16384 * 4;
constexpr size_t OFF_OL = OFF_QP + (size_t)NTASK * 8192 * 2;
constexpr size_t OFF_SH = OFF_OL + (size_t)NTASK * 8192 * 4;
constexpr size_t OFF_EG = OFF_SH + (size_t)NTASK * 16384 * 2;
constexpr size_t OFF_UW = OFF_EG + 4096;
constexpr size_t OFF_BONUS = OFF_UW + (size_t)NTASK * 16384 * 4;
constexpr size_t OFF_GATE = OFF_BONUS + (size_t)SEG * 1024 * 4;
constexpr size_t OFF_SZ = OFF_GATE + (size_t)SEG * 1024 * 4;
constexpr size_t OFF_ORW = OFF_SZ + (size_t)SEG * 1024 * 4;
constexpr size_t OFF_OGD = OFF_ORW + (size_t)SEG * 1024 * 4;
constexpr int RTASK = (SEG / 64) * 16;
constexpr size_t OFF_RPM = OFF_OGD;
constexpr size_t OFF_RRM = OFF_RPM + (size_t)RTASK * 4096 * 2;
constexpr size_t OFF_RQP = OFF_RRM + (size_t)RTASK * 4096 * 4;
constexpr size_t OFF_ROL = OFF_RQP + (size_t)RTASK * 4096 * 2;
constexpr size_t OFF_RZH = OFF_ROL + (size_t)RTASK * 4096 * 4;
constexpr size_t OFF_RPC = OFF_RZH + (size_t)RTASK * 4096 * 2;
constexpr size_t OFF_XS = OFF_RPC + (size_t)RTASK * 64 * 4;
constexpr size_t OFF_END1 = OFF_XS + (size_t)256 * 8192 * 4;
constexpr size_t OFF_BAR = OFF_END1;
constexpr size_t OFF_U = OFF_AB1;
constexpr size_t OFF_END2 = OFF_U + (size_t)T * DFF * 2;
static_assert(OFF_BAR + 16384 <= 536870912ull, "ws overflow 1");
static_assert(OFF_END2 <= 536870912ull, "ws overflow 2");

constexpr int LDS_BYTES = 163840;
constexpr int RC_AAB = 0, RC_PS = 16384, RC_ATF = 18432, RC_RTF = 35840, RC_ATB = 53248, RC_RTB = 62464, RC_BIB = 71680, RC_KIB = 80896, RC_BTT = 90112, RC_KTT = 99328, RC_VT = 108544, RC_AAK = 117760, RC_ARB = 126976, RC_ARK = 136192, RC_CMF = 145408;
constexpr int GP_SM = 0, GP_MM = 1024, GP_AM = 17408, GP_QF = 33792, GP_KF = 67584, GP_VF = 101376, GP_KTT = 135168, GP_AB = 153600;

struct Params {
    const float* in[30];
    float* out;
    unsigned char* ws;
};

__device__ __forceinline__ bf16_t f2bf(float f) { unsigned u = __float_as_uint(f); u += 0x7FFFu + ((u >> 16) & 1u); return (bf16_t)(u >> 16); }
typedef __bf16 bf16v2 __attribute__((ext_vector_type(2)));
__device__ __forceinline__ unsigned pack2(float a, float b) { const f32x2 v = (f32x2){a, b}; const bf16v2 h = __builtin_convertvector(v, bf16v2); return __builtin_bit_cast(unsigned, h); }
__device__ __forceinline__ f32x4 mfma16(bf16x8 a, bf16x8 b, f32x4 c) { return __builtin_amdgcn_mfma_f32_16x16x32_bf16(a, b, c, 0, 0, 0); }
__device__ __forceinline__ float sigmoidf_(float x) { return 1.f / (1.f + __expf(-x)); }
__device__ __forceinline__ float softplusf_(float x) { return x > 20.f ? x : log1pf(__expf(x)); }
__device__ __forceinline__ float siluf_(float x) { return x / (1.f + __expf(-x)); }
template <int CTRL> __device__ __forceinline__ float dppf(float x) { return __int_as_float(__builtin_amdgcn_update_dpp(0, __float_as_int(x), CTRL, 0xF, 0xF, false)); }
__device__ __forceinline__ float allred16(float x) {
    x += dppf<0xB1>(x);
    x += dppf<0x4E>(x);
    x += dppf<0x124>(x);
    x += dppf<0x128>(x);
    return x;
}
__device__ __forceinline__ float wsum(float v) { v = allred16(v); v += __shfl_xor(v, 16); v += __shfl_xor(v, 32); return v; }

__device__ __forceinline__ int lbid() { int b = blockIdx.x; asm volatile("" : "+v"(b)); return __builtin_amdgcn_readfirstlane(b); }
__device__ __forceinline__ int ltid() { int t = threadIdx.x; asm volatile("" : "+v"(t)); return t; }


#define XB_TMO      128
#define XB_XCNT(j)  (256  + 64 * (j))
#define XB_XSUB(j)  (1280 + 64 * (j))
#define XB_XGEN(j)  (2304 + 64 * (j))
#define XB_TOP      3328
#define XB_TOPGEN   3392
#define XCD_BAR_WORDS 3456
#define XB_SPIN_CAP (1u << 22)
__device__ __forceinline__ unsigned xb_ld(unsigned* p)              { return __hip_atomic_load(p, __ATOMIC_RELAXED, __HIP_MEMORY_SCOPE_AGENT); }
__device__ __forceinline__ unsigned xb_add(unsigned* p, unsigned v) { return __hip_atomic_fetch_add(p, v, __ATOMIC_RELAXED, __HIP_MEMORY_SCOPE_AGENT); }
__device__ __forceinline__ unsigned xb_xcc_id() { return (unsigned)__builtin_amdgcn_s_getreg((3 << 11) | 20) & 0xFu; }
#define XB_SPIN(cond, bar) do { unsigned _sp = 0; while (cond) { __builtin_amdgcn_s_sleep(1); \
    if ((++_sp & 255u) == 0u) { if (xb_ld(&(bar)[XB_TMO])) break; if (_sp > XB_SPIN_CAP) { atomicAdd(&(bar)[XB_TMO], 1u); break; } } } } while (0)
struct XcdBarrier { unsigned* bar; unsigned x; volatile LAS unsigned* st; };
__device__ __forceinline__ XcdBarrier xcd_barrier_post(unsigned* bar, volatile LAS unsigned* st) {
    XcdBarrier b; b.bar = bar; b.x = xb_xcc_id(); b.st = st;
    if (threadIdx.x == 0) (void)xb_add(&bar[XB_XCNT(b.x)], 1u);
    return b;
}
__device__ __forceinline__ void xcd_barrier_complete(unsigned* bar, unsigned x, unsigned& nloc, unsigned& nx) {
    const unsigned G = gridDim.x * gridDim.y * gridDim.z;
    unsigned sum, cnt, mine, sp = 0u;
    for (;;) {
        sum = 0u; cnt = 0u; mine = 0u;
#pragma unroll
        for (unsigned j = 0; j < 16; ++j) { const unsigned c = xb_ld(&bar[XB_XCNT(j)]); sum += c; cnt += (c > 0u) ? 1u : 0u; mine = (j == x) ? c : mine; }
        if (sum == G) break;
        __builtin_amdgcn_s_sleep(1);
        if ((++sp & 255u) == 0u) { if (xb_ld(&bar[XB_TMO])) break; if (sp > XB_SPIN_CAP) { atomicAdd(&bar[XB_TMO], 1u); break; } }
    }
    nloc = mine > 0u ? mine : 1u; nx = cnt > 0u ? cnt : 1u;
}
__device__ __forceinline__ void xcd_barrier(const XcdBarrier& b) {
    asm volatile("s_waitcnt vmcnt(0)" ::: "memory");
    __syncthreads();
    if (threadIdx.x == 0) {
        unsigned* bar = b.bar;
        __builtin_amdgcn_s_waitcnt(0);
        unsigned nloc = b.st[0], nx = b.st[1];
        if (nloc == 0u) { xcd_barrier_complete(bar, b.x, nloc, nx); b.st[0] = nloc; b.st[1] = nx; }
        const unsigned old = xb_add(&bar[XB_XSUB(b.x)], 1u);
        const unsigned gen = old / nloc;
        if (old + 1u == (gen + 1u) * nloc) {
            __builtin_amdgcn_fence(__ATOMIC_RELEASE, "agent");
            asm volatile("s_waitcnt vmcnt(0)" ::: "memory");
            const unsigned og = xb_add(&bar[XB_TOP], 1u);
            const unsigned tg = og / nx;
            if (og + 1u == (tg + 1u) * nx) xb_add(&bar[XB_TOPGEN], 1u);
            else XB_SPIN(xb_ld(&bar[XB_TOPGEN]) == tg, bar);
            __builtin_amdgcn_fence(__ATOMIC_ACQUIRE, "agent");
            xb_add(&bar[XB_XGEN(b.x)], 1u);
            asm volatile("s_waitcnt vmcnt(0)" ::: "memory");
        } else {
            XB_SPIN(xb_ld(&bar[XB_XGEN(b.x)]) == gen, bar);
            __builtin_amdgcn_fence(__ATOMIC_ACQUIRE, "agent");
            asm volatile("s_waitcnt vmcnt(0)" ::: "memory");
        }
    }
    __syncthreads();
}

namespace pg8 {
constexpr int BM = 256, BK = 64, HALF = 128, HTB = HALF * BK * 2, NXCD = 8, WGM = 8;
__device__ __forceinline__ int lds_byte(int r, int c) { const int st = (r >> 4) * 2 + (c >> 5), rr = r & 15, cc = c & 31, ob = rr * 64 + cc * 2; return st * 1024 + (ob ^ (((ob >> 9) & 1) << 5)); }
__device__ __forceinline__ int perm32(int rho) { const int n = rho >> 4, i = rho & 15; return 8 * (i >> 2) + 4 * n + (i & 3); }
__device__ __forceinline__ void stage_rc(int b, int& R, int& C) { const int st = b / 1024, sb = b % 1024, swz = sb ^ (((sb >> 9) & 1) << 5); R = (st >> 1) * 16 + swz / 64; C = (st & 1) * 32 + (swz % 64) / 2; }

struct Unit { int pm, pn, b; };
struct Gemm { const bf16_t* A; const bf16_t* Bt; int lda, ldb, K, nM, nN, nB; size_t sA, sB; };

struct Order {
    int nM, nN, per, nwg, G, c;
    __device__ void init(const Gemm& g, int G_, int c_) { nM = g.nM; nN = g.nN; per = nM * nN; nwg = per * g.nB; G = G_; c = c_; }
    __device__ bool next(int i, Unit& u) const {
        const long L = (long)i * G + c; if (L >= nwg) return false;
        u.b = (int)(L / per); int wgid = (int)(L % per);
        { const int q = per / NXCD, r = per % NXCD, xcd = wgid % NXCD, off = wgid / NXCD; wgid = (xcd < r ? xcd * (q + 1) : r * (q + 1) + (xcd - r) * q) + off; }
        const int nig = WGM * nN, gid = wgid / nig, fm = gid * WGM, gsz = (nM - fm) < WGM ? (nM - fm) : WGM;
        u.pm = fm + ((wgid % nig) % gsz); u.pn = (wgid % nig) / gsz; return true;
    }
};

template <class Epi>
__device__ __forceinline__ void gemm_phase(LAS unsigned char* lds, const Gemm g, const Order& S, const Epi& E) {
    int tid_ = threadIdx.x; asm volatile("" : "+v"(tid_));
    const int tid = tid_, wid = __builtin_amdgcn_readfirstlane(tid >> 6), lane = tid & 63, wr = wid >> 2, wc = wid & 3, fr = lane & 15, fq = lane >> 4;
    const int K = g.K, nt = K / BK;
    unsigned voffA[2], voffB[2];
#pragma unroll
    for (int i = 0; i < 2; ++i) { int R, C; stage_rc(tid * 16 + i * 8192, R, C);
        const int Rb = Epi::PERM ? ((R & ~31) + perm32(R & 31)) : R;
        voffA[i] = (unsigned)(R * g.lda + C) * 2u; voffB[i] = (unsigned)(Rb * g.ldb + C) * 2u; }
    const size_t kstep = (size_t)(BK * 2);
    const size_t hstepA = (size_t)HALF * g.lda * 2, hstepB = (size_t)HALF * g.ldb * 2;
    const size_t tstepA = 2 * hstepA, tstepB = 2 * hstepB;
    const unsigned ldsw = (unsigned)wid * 1024u;
    const int aoff = lds_byte(wr * 64 + fr, fq * 8), boff = lds_byte(wc * 32 + fr, fq * 8);
#define PG8_SA(b, h) (((b) * 2 + (h)) * HTB)
#define PG8_SB(b, h) ((4 + (b) * 2 + (h)) * HTB)
#define PG8_STAGE(bufoff, gbase, voff) do { _Pragma("unroll") for (int _i = 0; _i < 2; ++_i) \
        __builtin_amdgcn_global_load_lds((const unsigned*)((const char*)(gbase) + (voff)[_i]), (LAS unsigned*)(lds + (bufoff) + ldsw + _i * 8192), 16, 0, 0); } while (0)
#define PG8_LDA(dst, b, h) do { _Pragma("unroll") for (int m = 0; m < 4; ++m) _Pragma("unroll") for (int k = 0; k < 2; ++k) dst[m][k] = *(const LAS bf16x8*)(lds + PG8_SA(b, h) + aoff + m * 2048 + k * 1024); } while (0)
#define PG8_LDB(dst, b, h) do { _Pragma("unroll") for (int n = 0; n < 2; ++n) _Pragma("unroll") for (int k = 0; k < 2; ++k) dst[n][k] = *(const LAS bf16x8*)(lds + PG8_SB(b, h) + boff + n * 2048 + k * 1024); } while (0)
#define PG8_MMA(ai, bj, At, Bt) do { __builtin_amdgcn_s_setprio(1); _Pragma("unroll") for (int m = 0; m < 4; ++m) _Pragma("unroll") for (int n = 0; n < 2; ++n) _Pragma("unroll") for (int k = 0; k < 2; ++k) \
        acc[ai][bj][m][n] = __builtin_amdgcn_mfma_f32_16x16x32_bf16(Bt[n][k], At[m][k], acc[ai][bj][m][n], 0, 0, 0); __builtin_amdgcn_s_setprio(0); } while (0)
#define PG8_WAIT_V(n) asm volatile("s_waitcnt vmcnt(" #n ")" ::: "memory")
#define PG8_WAIT_L(n) asm volatile("s_waitcnt lgkmcnt(" #n ")" ::: "memory")
#define PG8_BAR __builtin_amdgcn_s_barrier()
#define PG8_SCHED __builtin_amdgcn_sched_barrier(0)
    Unit cur, nxt; int ui = 0;
    if (!S.next(0, cur)) return;
    f32x4 acc[2][2][4][2];
#pragma unroll
    for (int a = 0; a < 2; ++a)
#pragma unroll
        for (int b = 0; b < 2; ++b)
#pragma unroll
            for (int m = 0; m < 4; ++m)
#pragma unroll
                for (int n = 0; n < 2; ++n) acc[a][b][m][n] = (f32x4){0.f, 0.f, 0.f, 0.f};
    bf16x8 At[4][2], B0[2][2], B1[2][2];
    const char* cA = (const char*)g.A + (size_t)cur.b * g.sA * 2 + (size_t)cur.pm * tstepA; const char* cB = (const char*)g.Bt + (size_t)cur.b * g.sB * 2 + (size_t)cur.pn * tstepB;
    PG8_STAGE(PG8_SB(0, 0), cB, voffB); PG8_STAGE(PG8_SA(0, 0), cA, voffA); PG8_STAGE(PG8_SB(0, 1), cB + hstepB, voffB); PG8_STAGE(PG8_SA(0, 1), cA + hstepA, voffA);
    if (wr == 1) PG8_BAR;
    PG8_WAIT_V(4); PG8_BAR;
    PG8_STAGE(PG8_SB(1, 0), cB + kstep, voffB); PG8_STAGE(PG8_SA(1, 0), cA + kstep, voffA); PG8_STAGE(PG8_SB(1, 1), cB + hstepB + kstep, voffB);
    PG8_WAIT_V(6); PG8_BAR;
    for (;;) {
        const bool has_next = S.next(ui + 1, nxt);
        const char* nA = has_next ? (const char*)g.A + (size_t)nxt.b * g.sA * 2 + (size_t)nxt.pm * tstepA : cA; const char* nB = has_next ? (const char*)g.Bt + (size_t)nxt.b * g.sB * 2 + (size_t)nxt.pn * tstepB : cB;
        for (int t = 0; t < nt; t += 2) {
            const bool last = (t == nt - 2);
            const char* a1 = cA + (size_t)(t + 1) * kstep;
            const char* a2 = last ? nA : cA + (size_t)(t + 2) * kstep; const char* b2 = last ? nB : cB + (size_t)(t + 2) * kstep;
            const char* a3 = a2 + kstep; const char* b3 = b2 + kstep;
            PG8_LDB(B0, 0, 0); PG8_SCHED; PG8_LDA(At, 0, 0); PG8_STAGE(PG8_SA(1, 1), a1 + hstepA, voffA);
            PG8_WAIT_L(8); PG8_BAR; PG8_WAIT_L(0); PG8_MMA(0, 0, At, B0); PG8_BAR; PG8_SCHED;
            PG8_LDB(B1, 0, 1); PG8_STAGE(PG8_SB(0, 0), b2, voffB);
            PG8_BAR; PG8_WAIT_L(0); PG8_MMA(0, 1, At, B1); PG8_BAR;
            PG8_LDA(At, 0, 1); PG8_STAGE(PG8_SA(0, 0), a2, voffA);
            PG8_BAR; PG8_WAIT_L(0); PG8_MMA(1, 0, At, B0); PG8_BAR; PG8_SCHED;
            PG8_STAGE(PG8_SB(0, 1), b2 + hstepB, voffB);
            PG8_WAIT_V(6); PG8_BAR; PG8_MMA(1, 1, At, B1); PG8_BAR;
            PG8_LDB(B0, 1, 0); PG8_SCHED; PG8_LDA(At, 1, 0); PG8_STAGE(PG8_SA(0, 1), a2 + hstepA, voffA);
            PG8_WAIT_L(8); PG8_BAR; PG8_WAIT_L(0); PG8_MMA(0, 0, At, B0); PG8_BAR; PG8_SCHED;
            PG8_LDB(B1, 1, 1); PG8_STAGE(PG8_SB(1, 0), b3, voffB);
            PG8_BAR; PG8_WAIT_L(0); PG8_MMA(0, 1, At, B1); PG8_BAR;
            PG8_LDA(At, 1, 1); PG8_STAGE(PG8_SA(1, 0), a3, voffA);
            PG8_BAR; PG8_WAIT_L(0); PG8_MMA(1, 0, At, B0); PG8_BAR; PG8_SCHED;
            PG8_STAGE(PG8_SB(1, 1), b3 + hstepB, voffB);
            PG8_WAIT_V(6); PG8_BAR; PG8_MMA(1, 1, At, B1); PG8_BAR;
        }
        E(acc, cur, wr, wc, fr, fq);
        if (!has_next) break;
#pragma unroll
        for (int a = 0; a < 2; ++a)
#pragma unroll
            for (int b = 0; b < 2; ++b)
#pragma unroll
                for (int m = 0; m < 4; ++m)
#pragma unroll
                    for (int n = 0; n < 2; ++n) acc[a][b][m][n] = (f32x4){0.f, 0.f, 0.f, 0.f};
        cur = nxt; cA = nA; cB = nB; ++ui;
    }
    PG8_WAIT_V(0);
    if (wr == 0) PG8_BAR;
    PG8_BAR;
#undef PG8_SA
#undef PG8_SB
#undef PG8_STAGE
#undef PG8_LDA
#undef PG8_LDB
#undef PG8_MMA
#undef PG8_WAIT_V
#undef PG8_WAIT_L
#undef PG8_BAR
#undef PG8_SCHED
}
}
using pg8::Unit;
using pg8::Gemm;

__device__ __forceinline__ float rs_from(const float* ssq, int row) {
    const float4* p = (const float4*)(ssq + (size_t)row * 32); float s = 0.f;
#pragma unroll
    for (int i = 0; i < 8; ++i) { float4 v = p[i]; s += (v.x + v.y) + (v.z + v.w); }
    return rsqrtf(s * (1.f / 2048.f) + 1e-6f);
}
__device__ __forceinline__ void rs8_from(const float* ssq, int row0, int fq, float (&rs)[8]) {
    float4 pa[8], pb[8];
#pragma unroll
    for (int i = 0; i < 8; ++i) { const float4* p4 = (const float4*)(ssq + (size_t)(row0 + (i >> 2) * 128 + (i & 3) * 16) * 32) + fq * 2; pa[i] = p4[0]; pb[i] = p4[1]; }
#pragma unroll
    for (int i = 0; i < 8; ++i) { float v = ((pa[i].x + pa[i].y) + (pa[i].z + pa[i].w)) + ((pb[i].x + pb[i].y) + (pb[i].z + pb[i].w));
        v += __shfl_xor(v, 16); v += __shfl_xor(v, 32); rs[i] = rsqrtf(v * (1.f / 2048.f) + 1e-6f); }
}
__device__ __forceinline__ void rs8_cached(const float* ssq, LAS float* cache, int pm, int row0, int wr, int wc, int fr, int fq, float (&rs)[8]) {
    LAS float* sl = cache + (((wr * 4 + wc) * 64) + fq * 16 + fr) * 12;
    if (__float_as_int(sl[0]) == pm) {
        const f32x4 a = *(const LAS f32x4*)(sl + 4), b = *(const LAS f32x4*)(sl + 8);
        rs[0] = a[0]; rs[1] = a[1]; rs[2] = a[2]; rs[3] = a[3]; rs[4] = b[0]; rs[5] = b[1]; rs[6] = b[2]; rs[7] = b[3];
    } else {
        rs8_from(ssq, row0, fq, rs);
        *(LAS f32x4*)(sl + 4) = (f32x4){rs[0], rs[1], rs[2], rs[3]}; *(LAS f32x4*)(sl + 8) = (f32x4){rs[4], rs[5], rs[6], rs[7]};
        sl[0] = __int_as_float(pm);
    }
}
struct EpiY {
    static constexpr bool PERM = false;
    float* Y; int ldc; const float* rstd;
    __device__ __forceinline__ void operator()(const f32x4 (&acc)[2][2][4][2], const Unit& u, int wr, int wc, int fr, int fq) const {
        const int row0 = u.pm * 256 + wr * 64 + fr, col0 = u.pn * 256 + wc * 32 + 4 * fq;
        float rs[8];
#pragma unroll
        for (int i = 0; i < 8; ++i) rs[i] = rstd[row0 + (i >> 2) * 128 + (i & 3) * 16];
        __builtin_amdgcn_sched_barrier(0);
#pragma unroll
        for (int ai = 0; ai < 2; ++ai)
#pragma unroll
            for (int m = 0; m < 4; ++m) { const int row = row0 + ai * 128 + m * 16; float* rowp = Y + (size_t)row * ldc + col0;
#pragma unroll
                for (int bj = 0; bj < 2; ++bj)
#pragma unroll
                    for (int n = 0; n < 2; ++n) *(f32x4*)(rowp + bj * 128 + n * 16) = acc[ai][bj][m][n] * rs[ai * 4 + m]; }
    }
};
__device__ __forceinline__ uint4 pack8(f32x4 a, f32x4 b) { uint4 o; o.x = pack2(a[0], a[1]); o.y = pack2(a[2], a[3]); o.z = pack2(b[0], b[1]); o.w = pack2(b[2], b[3]); return o; }
struct EpiBf {
    static constexpr bool PERM = true;
    bf16_t* O; int ldc; const float* ssq; LAS float* cache;
    __device__ __forceinline__ void operator()(const f32x4 (&acc)[2][2][4][2], const Unit& u, int wr, int wc, int fr, int fq) const {
        const int row0 = u.pm * 256 + wr * 64 + fr, col0 = u.pn * 256 + wc * 32 + 8 * fq;
        float rs[8];
        if (ssq) rs8_cached(ssq, cache, u.pm, row0, wr, wc, fr, fq, rs); else {
#pragma unroll
            for (int i = 0; i < 8; ++i) rs[i] = 1.f; }
        __builtin_amdgcn_sched_barrier(0);
#pragma unroll
        for (int ai = 0; ai < 2; ++ai)
#pragma unroll
            for (int m = 0; m < 4; ++m) { const int row = row0 + ai * 128 + m * 16; bf16_t* rowp = O + (size_t)row * ldc + col0; const float r1 = rs[ai * 4 + m];
#pragma unroll
                for (int bj = 0; bj < 2; ++bj) *(uint4*)(rowp + bj * 128) = pack8(acc[ai][bj][m][0] * r1, acc[ai][bj][m][1] * r1); }
    }
};
struct EpiUp {
    static constexpr bool PERM = true;
    bf16_t* O; int ldc; const float* ssq; LAS float* cache;
    __device__ __forceinline__ void operator()(const f32x4 (&acc)[2][2][4][2], const Unit& u, int wr, int wc, int fr, int fq) const {
        const int row0 = u.pm * 256 + wr * 64 + fr, col0 = u.pn * 256 + wc * 32 + 8 * fq;
        float rs[8];
        rs8_cached(ssq, cache, u.pm, row0, wr, wc, fr, fq, rs);
        __builtin_amdgcn_sched_barrier(0);
#pragma unroll
        for (int ai = 0; ai < 2; ++ai)
#pragma unroll
            for (int m = 0; m < 4; ++m) { const int row = row0 + ai * 128 + m * 16; bf16_t* rowp = O + (size_t)row * ldc + col0; const float r1 = rs[ai * 4 + m];
#pragma unroll
                for (int bj = 0; bj < 2; ++bj) { f32x4 v0 = acc[ai][bj][m][0] * r1, v1 = acc[ai][bj][m][1] * r1;
#pragma unroll
                    for (int j = 0; j < 4; ++j) { const float a = fmaxf(v0[j], 0.f), b = fmaxf(v1[j], 0.f); v0[j] = a * a; v1[j] = b * b; }
                    { const uint4 pk = pack8(v0, v1); __builtin_nontemporal_store((u32x4){pk.x, pk.y, pk.z, pk.w}, (u32x4*)(rowp + bj * 128)); } } }
    }
};
template <bool WH32, bool WHB> struct EpiRes {
    static constexpr bool PERM = !WH32;
    const bf16_t* Rb; float* H; bf16_t* HB; float* ssq;
    __device__ __forceinline__ void operator()(const f32x4 (&acc)[2][2][4][2], const Unit& u, int wr, int wc, int fr, int fq) const {
        const int row0 = u.pm * 256 + wr * 64 + fr;
        if constexpr (PERM) {
            const int col0 = u.pn * 256 + wc * 32 + 8 * fq;
#pragma unroll
            for (int ai = 0; ai < 2; ++ai) {
                uint4 rv[4][2];
#pragma unroll
                for (int m = 0; m < 4; ++m)
#pragma unroll
                    for (int bj = 0; bj < 2; ++bj) rv[m][bj] = *(const uint4*)(Rb + (size_t)(row0 + ai * 128 + m * 16) * 2048 + col0 + bj * 128);
                __builtin_amdgcn_sched_barrier(0);
#pragma unroll
                for (int m = 0; m < 4; ++m) { const int row = row0 + ai * 128 + m * 16; const size_t ro = (size_t)row * 2048 + col0; float s = 0.f;
#pragma unroll
                    for (int bj = 0; bj < 2; ++bj) { const uint4 rb = rv[m][bj]; f32x4 v0 = acc[ai][bj][m][0], v1 = acc[ai][bj][m][1];
                        v0[0] += __uint_as_float(rb.x << 16); v0[1] += __uint_as_float(rb.x & 0xFFFF0000u); v0[2] += __uint_as_float(rb.y << 16); v0[3] += __uint_as_float(rb.y & 0xFFFF0000u);
                        v1[0] += __uint_as_float(rb.z << 16); v1[1] += __uint_as_float(rb.z & 0xFFFF0000u); v1[2] += __uint_as_float(rb.w << 16); v1[3] += __uint_as_float(rb.w & 0xFFFF0000u);
                        s += (v0[0] * v0[0] + v0[1] * v0[1] + v0[2] * v0[2] + v0[3] * v0[3]) + (v1[0] * v1[0] + v1[1] * v1[1] + v1[2] * v1[2] + v1[3] * v1[3]);
                        if (WHB) *(uint4*)(HB + ro + bj * 128) = pack8(v0, v1); }
                    if (ssq) { s += __shfl_xor(s, 16); s += __shfl_xor(s, 32); if (fq == 0) ssq[(size_t)row * 32 + u.pn * 4 + wc] = s; } }
                __builtin_amdgcn_sched_barrier(0);
            }
        } else {
            const int col0 = u.pn * 256 + wc * 32 + 4 * fq;
#pragma unroll
            for (int ai = 0; ai < 2; ++ai) {
                uint2 rv[4][2][2];
#pragma unroll
                for (int m = 0; m < 4; ++m)
#pragma unroll
                    for (int bj = 0; bj < 2; ++bj)
#pragma unroll
                        for (int n = 0; n < 2; ++n) rv[m][bj][n] = *(const uint2*)(Rb + (size_t)(row0 + ai * 128 + m * 16) * 2048 + col0 + bj * 128 + n * 16);
                __builtin_amdgcn_sched_barrier(0);
#pragma unroll
                for (int m = 0; m < 4; ++m) { const int row = row0 + ai * 128 + m * 16; const size_t ro = (size_t)row * 2048 + col0; float s = 0.f;
#pragma unroll
                    for (int bj = 0; bj < 2; ++bj)
#pragma unroll
                        for (int n = 0; n < 2; ++n) { const size_t o = ro + bj * 128 + n * 16; const uint2 rb = rv[m][bj][n];
                            f32x4 v = acc[ai][bj][m][n];
                            v[0] += __uint_as_float(rb.x << 16); v[1] += __uint_as_float(rb.x & 0xFFFF0000u); v[2] += __uint_as_float(rb.y << 16); v[3] += __uint_as_float(rb.y & 0xFFFF0000u);
                            if (WH32) *(f32x4*)(H + o) = v;
                            s += v[0] * v[0] + v[1] * v[1] + v[2] * v[2] + v[3] * v[3]; }
                    if (ssq) { s += __shfl_xor(s, 16); s += __shfl_xor(s, 32); if (fq == 0) ssq[(size_t)row * 32 + u.pn * 4 + wc] = s; } }
                __builtin_amdgcn_sched_barrier(0);
            }
        }
    }
};
struct EpiScore {
    static constexpr bool PERM = true;
    bf16_t* P; float* prow; float scale;
    __device__ __forceinline__ void operator()(const f32x4 (&acc)[2][2][4][2], const Unit& u, int wr, int wc, int fr, int fq) const {
        const int row0 = u.pm * 256 + wr * 64 + fr, col0 = u.b * 256 + wc * 32 + 8 * fq;
#pragma unroll
        for (int ai = 0; ai < 2; ++ai)
#pragma unroll
            for (int m = 0; m < 4; ++m) { const int row = row0 + ai * 128 + m * 16; bf16_t* rowp = P + (size_t)row * 1024 + col0; float s = 0.f;
#pragma unroll
                for (int bj = 0; bj < 2; ++bj) { f32x4 v0 = acc[ai][bj][m][0] * scale, v1 = acc[ai][bj][m][1] * scale;
#pragma unroll
                    for (int j = 0; j < 4; ++j) { v0[j] = __expf(fminf(v0[j], 80.f)); v1[j] = __expf(fminf(v1[j], 80.f)); s += v0[j] + v1[j]; }
                    *(uint4*)(rowp + bj * 128) = pack8(v0, v1); }
                s += __shfl_xor(s, 16); s += __shfl_xor(s, 32); if (fq == 0) prow[(size_t)row * 16 + u.b * 4 + wc] = s; }
    }
};
struct EpiPV {
    static constexpr bool PERM = true;
    bf16_t* O; const float* prow;
    __device__ __forceinline__ void operator()(const f32x4 (&acc)[2][2][4][2], const Unit& u, int wr, int wc, int fr, int fq) const {
        const int row0 = u.pm * 256 + wr * 64 + fr, col0 = u.b * 512 + u.pn * 256 + wc * 32 + 8 * fq;
        float inv[8];
        { float4 pr[8];
#pragma unroll
          for (int i = 0; i < 8; ++i) pr[i] = *(const float4*)(prow + (size_t)(row0 + (i >> 2) * 128 + (i & 3) * 16) * 16 + u.b * 4);
#pragma unroll
          for (int i = 0; i < 8; ++i) inv[i] = 1.f / ((pr[i].x + pr[i].y) + (pr[i].z + pr[i].w)); }
        __builtin_amdgcn_sched_barrier(0);
#pragma unroll
        for (int ai = 0; ai < 2; ++ai)
#pragma unroll
            for (int m = 0; m < 4; ++m) { const int row = row0 + ai * 128 + m * 16; bf16_t* rowp = O + (size_t)row * 2048 + col0; const float r1 = inv[ai * 4 + m];
#pragma unroll
                for (int bj = 0; bj < 2; ++bj) *(uint4*)(rowp + bj * 128) = pack8(acc[ai][bj][m][0] * r1, acc[ai][bj][m][1] * r1); }
    }
};

template <class Epi>
__device__ __forceinline__ void run_gemm(LAS unsigned char* lds, const bf16_t* A, const bf16_t* Bt, int lda, int ldb, int K, int nM, int nN, int nB, size_t sA, size_t sB, const Epi& E, int cshift, int G = 0, int cc = -1) {
    Gemm g; g.A = A; g.Bt = Bt; g.lda = lda; g.ldb = ldb; g.K = K; g.nM = nM; g.nN = nN; g.nB = nB; g.sA = sA; g.sB = sB;
    pg8::Order S; if (cc >= 0) S.init(g, G, cc); else S.init(g, (int)gridDim.x, (int)((blockIdx.x + cshift) % gridDim.x));
    pg8::gemm_phase<Epi>(lds, g, S, E);
}

__device__ __forceinline__ void convT(const float* __restrict__ src, bf16_t* __restrict__ dst, const float* __restrict__ gain, int K, int N, int Npad, float* tile, int bid = -1, int nb = 0, int t0 = 0, int t1 = 1 << 30) {
    const int tidx = ltid();
    const int tn = Npad / 64; int ntile = (K / 64) * tn; if (t1 < ntile) ntile = t1;
    if (bid < 0) { bid = blockIdx.x; nb = gridDim.x; }
    const int nn = tidx & 63, kb = tidx >> 6, kp = (tidx & 31) * 2, nb2 = tidx >> 5;
    float* tile2 = tile + 64 * 65;
    for (int t = t0 + bid; t < ntile; t += 2 * nb) {
        const int tB = t + nb; const bool hasB = tB < ntile;
        const int k0 = (t / tn) * 64, n0 = (t % tn) * 64, k1 = hasB ? (tB / tn) * 64 : k0, n1 = hasB ? (tB % tn) * 64 : n0;
        float va[8], vb[8];
#pragma unroll
        for (int i = 0; i < 8; ++i) { const int kk = kb + 8 * i;
            va[i] = (n0 + nn < N) ? __builtin_nontemporal_load(src + (size_t)(k0 + kk) * N + n0 + nn) : 0.f;
            vb[i] = (n1 + nn < N) ? __builtin_nontemporal_load(src + (size_t)(k1 + kk) * N + n1 + nn) : 0.f; }
#pragma unroll
        for (int i = 0; i < 8; ++i) { const int kk = kb + 8 * i;
            if (gain) { va[i] *= gain[k0 + kk]; vb[i] *= gain[k1 + kk]; }
            tile[kk * 65 + nn] = va[i]; tile2[kk * 65 + nn] = vb[i]; }
        __syncthreads();
#pragma unroll
        for (int i = 0; i < 4; ++i) { const int n2 = nb2 + 16 * i;
            *(unsigned*)(dst + (size_t)(n0 + n2) * K + k0 + kp) = pack2(tile[kp * 65 + n2], tile[(kp + 1) * 65 + n2]);
            if (hasB) *(unsigned*)(dst + (size_t)(n1 + n2) * K + k1 + kp) = pack2(tile2[kp * 65 + n2], tile2[(kp + 1) * 65 + n2]); }
        __syncthreads();
    }
}
__device__ __forceinline__ void rows_to_bf16(const float* __restrict__ x, bf16_t* __restrict__ xb, float* __restrict__ rstd, const float* __restrict__ gain, int rows) {
    const int tidx = ltid();
    const int gw = blockIdx.x * 8 + (tidx >> 6), nw = gridDim.x * 8, lane = tidx & 63;
    for (int r0 = gw; r0 < rows; r0 += 2 * nw) {
        const int r1 = (r0 + nw < rows) ? r0 + nw : r0;
        const float4* p0 = (const float4*)(x + (size_t)r0 * 2048); const float4* p1 = (const float4*)(x + (size_t)r1 * 2048);
        float4 v0[8], v1[8]; float s0 = 0.f, s1 = 0.f;
#pragma unroll
        for (int i = 0; i < 8; ++i) { const f32x4 a = __builtin_nontemporal_load((const f32x4*)p0 + i * 64 + lane), b = __builtin_nontemporal_load((const f32x4*)p1 + i * 64 + lane);
            v0[i] = make_float4(a[0], a[1], a[2], a[3]); v1[i] = make_float4(b[0], b[1], b[2], b[3]); }
#pragma unroll
        for (int i = 0; i < 8; ++i) { s0 += v0[i].x * v0[i].x + v0[i].y * v0[i].y + v0[i].z * v0[i].z + v0[i].w * v0[i].w; s1 += v1[i].x * v1[i].x + v1[i].y * v1[i].y + v1[i].z * v1[i].z + v1[i].w * v1[i].w; }
        s0 = wsum(s0); s1 = wsum(s1);
        const float rs0 = rsqrtf(s0 * (1.f / 2048.f) + 1e-6f), rs1 = rsqrtf(s1 * (1.f / 2048.f) + 1e-6f);
        if (rstd && lane == 0) { rstd[r0] = rs0; rstd[r1] = rs1; }
#pragma unroll
        for (int i = 0; i < 8; ++i) { float4 w0 = v0[i], w1 = v1[i];
            if (gain) { const float4 gg = ((const float4*)gain)[i * 64 + lane];
                w0.x *= rs0 * gg.x; w0.y *= rs0 * gg.y; w0.z *= rs0 * gg.z; w0.w *= rs0 * gg.w; w1.x *= rs1 * gg.x; w1.y *= rs1 * gg.y; w1.z *= rs1 * gg.z; w1.w *= rs1 * gg.w; }
            uint2 o0, o1; o0.x = pack2(w0.x, w0.y); o0.y = pack2(w0.z, w0.w); o1.x = pack2(w1.x, w1.y); o1.y = pack2(w1.z, w1.w);
            *(uint2*)(xb + (size_t)r0 * 2048 + (size_t)(i * 64 + lane) * 4) = o0; *(uint2*)(xb + (size_t)r1 * 2048 + (size_t)(i * 64 + lane) * 4) = o1; }
    }
}

__device__ __forceinline__ float yget(const float* yseg, const float* carry_prev, int seg, int tl, int col) {
    if (tl >= 0) return yseg[(size_t)tl * NINP + col];
    if (seg == 0) return 0.f;
    return carry_prev[(size_t)(3 + tl) * NINP + col];
}
__device__ __forceinline__ void rwkv_prep_tile(const Params& p, int seg, int cn, int hp, float* act  ) {
    const int tidx = ltid();
    const float* yseg = (const float*)(p.ws + OFF_YSEG);
    const float* carry_prev = (const float*)(p.ws + OFF_CARRY) + (size_t)((seg + 1) & 1) * 3 * NINP;
    const float* mu = p.in[8]; const float* w0 = p.in[9]; const float* w2 = p.in[10]; const float* a0 = p.in[11]; const float* a2 = p.in[12]; const float* g2 = p.in[13];
    const float* k_k = p.in[14]; const float* k_a = p.in[15]; const float* r_k = p.in[16];
    float* rrec = (float*)(p.ws + OFF_RREC); float* bonus = (float*)(p.ws + OFF_BONUS); float* gate = (float*)(p.ws + OFF_GATE);
    const int tid = tidx, tl0 = cn * 64;
    __syncthreads();
    bf16_t* actb = (bf16_t*)act;
    float* lro = act + 37888 / 4;
    if (tid < 288) {
        const int i = tid, col = RW0 + 3072 + i;
        const float mui = mu[3072 + i];
        float prev = yget(yseg, carry_prev, seg, tl0 - 1, col);
#pragma unroll 1
        for (int t0 = 0; t0 < 64; t0 += 16) {
            float cv[16];
#pragma unroll
            for (int q = 0; q < 16; ++q) cv[q] = yseg[(size_t)(tl0 + t0 + q) * NINP + col];
#pragma unroll
            for (int q = 0; q < 16; ++q) { const float cur = cv[q]; const float yl = cur + (prev - cur) * mui; prev = cur;
                actb[(t0 + q) * 296 + i] = f2bf(i < 64 ? tanhf(yl) : (i < 128 ? yl : sigmoidf_(yl))); }
        }
    }
    __syncthreads();
    {
        const int r = tid & 15, qd = (tid & 63) >> 4, wv_ = tid >> 6, cB = hp * 128 + 16 * wv_ + r;
        bf16x8 bw[9];
#pragma unroll
        for (int ks = 0; ks < 9; ++ks) {
            const float* Wm = ks < 2 ? w2 : (ks < 4 ? a2 : g2); const int ib = ks < 2 ? ks * 32 : (ks < 4 ? (ks - 2) * 32 : (ks - 4) * 32);
            float t8[8];
#pragma unroll
            for (int e = 0; e < 8; ++e) t8[e] = Wm[(size_t)(ib + qd * 8 + e) * 1024 + cB];
#pragma unroll
            for (int e = 0; e < 8; ++e) bw[ks][e] = (short)f2bf(t8[e]);
        }
#pragma unroll
        for (int m = 0; m < 4; ++m) {
            f32x4 cw = (f32x4){0.f, 0.f, 0.f, 0.f}, ca = cw, cg = cw;
#pragma unroll
            for (int ks = 0; ks < 9; ++ks) { const bf16x8 af = *(const bf16x8*)(actb + (16 * m + r) * 296 + ks * 32 + qd * 8);
                if (ks < 2) cw = mfma16(af, bw[ks], cw); else if (ks < 4) ca = mfma16(af, bw[ks], ca); else cg = mfma16(af, bw[ks], cg); }
#pragma unroll
            for (int j = 0; j < 4; ++j) { const int o = (16 * m + qd * 4 + j) * 132 + 16 * wv_ + r; lro[o] = cw[j]; lro[64 * 132 + o] = ca[j]; lro[2 * 64 * 132 + o] = cg[j]; }
        }
    }
    __syncthreads();
    {
        const int tg = tid >> 7, c = hp * 128 + (tid & 127), h = c >> 6, j = c & 63, tb = tl0 + tg * 16;
        float aw[16], aa[16], ag[16];
#pragma unroll
        for (int q = 0; q < 16; ++q) { const int o = (tg * 16 + q) * 132 + (tid & 127); aw[q] = lro[o]; aa[q] = lro[64 * 132 + o]; ag[q] = lro[2 * 64 * 132 + o]; }
        const float w0c = w0[c], a0c = a0[c], kkc = k_k[c], kac = k_a[c], rkc = r_k[c], mur = mu[c], muk = mu[1024 + c], muv = mu[2048 + c];
        float rp = yget(yseg, carry_prev, seg, tb - 1, RW0 + c), kp = yget(yseg, carry_prev, seg, tb - 1, RW0 + 1024 + c), vp = yget(yseg, carry_prev, seg, tb - 1, RW0 + 2048 + c);
        float rcv[16], kcv[16], vcv[16];
#pragma unroll
        for (int q = 0; q < 16; ++q) { rcv[q] = yseg[(size_t)(tb + q) * NINP + RW0 + c]; kcv[q] = yseg[(size_t)(tb + q) * NINP + RW0 + 1024 + c]; vcv[q] = yseg[(size_t)(tb + q) * NINP + RW0 + 2048 + c]; }
#pragma unroll
        for (int q = 0; q < 16; ++q) {
            const int tl = tb + q;
            const float rc = rcv[q], kc = kcv[q], vc = vcv[q];
            const float r = rc + (rp - rc) * mur, k = kc + (kp - kc) * muk, v = vc + (vp - vc) * muv;
            const float wlog = -softplusf_(-(w0c + aw[q])) - 0.5f;
            const float logdecay = -__expf(wlog);
            const float a = sigmoidf_(a0c + aa[q]);
            const float kx = k * kkc; const float n2 = wsum(kx * kx); const float kk = kx * rsqrtf(n2 + 1e-6f);
            const float k2 = k * (1.f + (a - 1.f) * kac);
            const float bsum = wsum(r * k2 * rkc);
            float* rec = rrec + ((size_t)tl * 16 + h) * RREC + j;
            rec[0] = logdecay; rec[64] = -kk; rec[128] = kk * a; rec[192] = k2; rec[256] = r; rec[320] = v;
            bonus[(size_t)tl * 1024 + c] = bsum * v; gate[(size_t)tl * 1024 + c] = ag[q];
            rp = rc; kp = kc; vp = vc;
        }
    }
}
template <int SIGN> __device__ __forceinline__ void solve64(float (&X)[64], const float* M) {
#pragma unroll
    for (int ib = 0; ib < 16; ++ib) {
        float s0 = 0.f, s1 = 0.f, s2 = 0.f, s3 = 0.f;
#pragma unroll
        for (int jj = 0; jj < ib; ++jj) {
            const float4 m0 = *(const float4*)(M + (4 * ib + 0) * 64 + 4 * jj), m1 = *(const float4*)(M + (4 * ib + 1) * 64 + 4 * jj);
            const float4 m2 = *(const float4*)(M + (4 * ib + 2) * 64 + 4 * jj), m3 = *(const float4*)(M + (4 * ib + 3) * 64 + 4 * jj);
            s0 += m0.x * X[4 * jj] + m0.y * X[4 * jj + 1] + m0.z * X[4 * jj + 2] + m0.w * X[4 * jj + 3];
            s1 += m1.x * X[4 * jj] + m1.y * X[4 * jj + 1] + m1.z * X[4 * jj + 2] + m1.w * X[4 * jj + 3];
            s2 += m2.x * X[4 * jj] + m2.y * X[4 * jj + 1] + m2.z * X[4 * jj + 2] + m2.w * X[4 * jj + 3];
            s3 += m3.x * X[4 * jj] + m3.y * X[4 * jj + 1] + m3.z * X[4 * jj + 2] + m3.w * X[4 * jj + 3];
        }
        const float4 d1 = *(const float4*)(M + (4 * ib + 1) * 64 + 4 * ib), d2 = *(const float4*)(M + (4 * ib + 2) * 64 + 4 * ib), d3 = *(const float4*)(M + (4 * ib + 3) * 64 + 4 * ib);
        X[4 * ib] += SIGN * s0;
        X[4 * ib + 1] += SIGN * (s1 + d1.x * X[4 * ib]);
        X[4 * ib + 2] += SIGN * (s2 + d2.x * X[4 * ib] + d2.y * X[4 * ib + 1]);
        X[4 * ib + 3] += SIGN * (s3 + d3.x * X[4 * ib] + d3.y * X[4 * ib + 1] + d3.z * X[4 * ib + 2]);
    }
}
__device__ __forceinline__ void rwkv_chunk_prep(const Params& p, int seg, int cn, int head, unsigned char* shm) {
    const int tidx = ltid(), wave = tidx >> 6, l = tidx & 63;
    const int task = cn * 16 + head, tl0 = cn * 64;
    const float* rrec = (const float*)(p.ws + OFF_RREC);
    float* AAB = (float*)(shm + RC_AAB); float* PS = (float*)(shm + RC_PS); float* ATF = (float*)(shm + RC_ATF); float* RTF = (float*)(shm + RC_RTF); float* CMF = (float*)(shm + RC_CMF);
    bf16_t* ATB = (bf16_t*)(shm + RC_ATB); bf16_t* RTB = (bf16_t*)(shm + RC_RTB); bf16_t* BIB = (bf16_t*)(shm + RC_BIB); bf16_t* KIB = (bf16_t*)(shm + RC_KIB);
    bf16_t* BTT = (bf16_t*)(shm + RC_BTT); bf16_t* KTT = (bf16_t*)(shm + RC_KTT); bf16_t* VT = (bf16_t*)(shm + RC_VT);
    bf16_t* AAK = (bf16_t*)(shm + RC_AAK); bf16_t* ARB = (bf16_t*)(shm + RC_ARB); bf16_t* ARK = (bf16_t*)(shm + RC_ARK);
    __syncthreads();
    {
        const int c = l, tq = wave;
        const float* rec0 = rrec + ((size_t)(tl0 + tq * 8) * 16 + head) * RREC + c;
        float lw[8], fa[8], fb[8], fk[8], fr[8], fv[8];
#pragma unroll
        for (int q = 0; q < 8; ++q) { const float* rec = rec0 + (size_t)q * 16 * RREC; lw[q] = rec[0]; fa[q] = rec[64]; fb[q] = rec[128]; fk[q] = rec[192]; fr[q] = rec[256]; fv[q] = rec[320]; }
        float run = 0.f;
#pragma unroll
        for (int q = 0; q < 8; ++q) { run += lw[q]; lw[q] = run; }
        PS[tq * 64 + c] = run;
        __syncthreads();
        float off = 0.f, tot = 0.f;
#pragma unroll
        for (int g = 0; g < 8; ++g) { const float v = PS[g * 64 + c]; off += (g < tq) ? v : 0.f; tot += v; }
#pragma unroll
        for (int q = 0; q < 8; ++q) {
            const int t = tq * 8 + q;
            const float Lt = off + lw[q], Lm = off + (q ? lw[q - 1] : 0.f);
            const float eP = __expf(Lt), ePm = __expf(Lm), eiP = __expf(-Lt), eT = __expf(tot - Lt);
            const float At = fa[q] * ePm, Rt = fr[q] * eP;
            ATF[t * 68 + c] = At; RTF[t * 68 + c] = Rt;
            ATB[t * 72 + c] = f2bf(At); RTB[t * 72 + c] = f2bf(Rt); BIB[t * 72 + c] = f2bf(fb[q] * eiP); KIB[t * 72 + c] = f2bf(fk[q] * eiP);
            BTT[c * 72 + t] = f2bf(fb[q] * eT); KTT[c * 72 + t] = f2bf(fk[q] * eT); VT[c * 72 + t] = f2bf(fv[q]);
        }
        if (tq == 0) ((float*)(p.ws + OFF_RPC))[(size_t)task * 64 + c] = __expf(tot);
    }
    __syncthreads();
    {
        const int t2 = ltid(); const int r = t2 & 15, qd = (t2 & 63) >> 4, w2_ = t2 >> 6, prod = w2_ >> 1, mb = (w2_ & 1) * 2;
        const bf16_t* Aop = (prod < 2) ? ATB : RTB; const bf16_t* Bop = (prod & 1) ? KIB : BIB;
#pragma unroll
        for (int mi = 0; mi < 2; ++mi) {
            const int m = mb + mi;
            const bf16x8 a0 = *(const bf16x8*)(Aop + (16 * m + r) * 72 + qd * 8), a1 = *(const bf16x8*)(Aop + (16 * m + r) * 72 + 32 + qd * 8);
#pragma unroll
            for (int n = 0; n < 4; ++n) {
                const bf16x8 b0 = *(const bf16x8*)(Bop + (16 * n + r) * 72 + qd * 8), b1 = *(const bf16x8*)(Bop + (16 * n + r) * 72 + 32 + qd * 8);
                f32x4 cacc = (f32x4){0.f, 0.f, 0.f, 0.f}; cacc = mfma16(a0, b0, cacc); cacc = mfma16(a1, b1, cacc);
#pragma unroll
                for (int j = 0; j < 4; ++j) { const int t = 16 * m + qd * 4 + j, sidx = 16 * n + r;
                    const bool keep = (prod < 2) ? (t > sidx) : (t >= sidx); const float val = keep ? cacc[j] : 0.f;
                    if (prod == 0) AAB[t * 64 + sidx] = val; else if (prod == 1) AAK[t * 72 + sidx] = f2bf(val); else if (prod == 2) ARB[t * 72 + sidx] = f2bf(val); else ARK[t * 72 + sidx] = f2bf(val); }
            }
        }
    }
    __syncthreads();
    {
        const int t3 = ltid(); const int r = t3 & 15, qd = (t3 & 63) >> 4, w3 = t3 >> 6, m = w3 & 3;
        const bf16x8 a0 = *(const bf16x8*)(AAK + (16 * m + r) * 72 + qd * 8), a1 = *(const bf16x8*)(AAK + (16 * m + r) * 72 + 32 + qd * 8);
#pragma unroll
        for (int nn = 0; nn < 2; ++nn) { const int n = (w3 >> 2) * 2 + nn;
            const bf16x8 b0 = *(const bf16x8*)(VT + (16 * n + r) * 72 + qd * 8), b1 = *(const bf16x8*)(VT + (16 * n + r) * 72 + 32 + qd * 8);
            f32x4 cacc = (f32x4){0.f, 0.f, 0.f, 0.f}; cacc = mfma16(a0, b0, cacc); cacc = mfma16(a1, b1, cacc);
#pragma unroll
            for (int j = 0; j < 4; ++j) CMF[(16 * m + qd * 4 + j) * 68 + 16 * n + r] = cacc[j]; }
    }
    __syncthreads();
    float* XSg = (float*)(p.ws + OFF_XS) + (size_t)blockIdx.x * 8192;
    if (tidx < 128) {
        float X[64];
        const int c = ltid();
        const float* srcp = (c < 64) ? (CMF + c) : (ATF + (c - 64));
#pragma unroll
        for (int i = 0; i < 64; ++i) X[i] = srcp[i * 68];
        solve64<1>(X, AAB);
#pragma unroll
        for (int i = 0; i < 64; ++i) XSg[i * 128 + c] = X[i];
    }
    __syncthreads();
    {
        const int t5 = ltid(); const int r = t5 & 15, qd = (t5 & 63) >> 4, m0 = ((t5 >> 6) & 3) * 16, half = t5 >> 8;
        bf16_t* RPM = (bf16_t*)(p.ws + OFF_RPM) + (size_t)task * 4096; float* RRM = (float*)(p.ws + OFF_RRM) + (size_t)task * 4096;
        bf16_t* RQP = (bf16_t*)(p.ws + OFF_RQP) + (size_t)task * 4096; float* ROL = (float*)(p.ws + OFF_ROL) + (size_t)task * 4096;
        bf16x8 aX[2];
#pragma unroll
        for (int ks = 0; ks < 2; ++ks)
#pragma unroll
            for (int e = 0; e < 8; ++e) aX[ks][e] = (short)f2bf(XSg[(ks * 32 + qd * 8 + e) * 128 + (half ? 0 : 64) + m0 + r]);
        if (half == 0) {
#pragma unroll
            for (int n = 0; n < 4; ++n) {
                const bf16x8 b0 = *(const bf16x8*)(BTT + (16 * n + r) * 72 + qd * 8), b1 = *(const bf16x8*)(BTT + (16 * n + r) * 72 + 32 + qd * 8);
                f32x4 cacc = (f32x4){0.f, 0.f, 0.f, 0.f}; cacc = mfma16(aX[0], b0, cacc); cacc = mfma16(aX[1], b1, cacc);
                uint2 o; o.x = pack2(cacc[0], cacc[1]); o.y = pack2(cacc[2], cacc[3]); *(uint2*)(RPM + (16 * n + r) * 64 + m0 + qd * 4) = o;
            }
#pragma unroll
            for (int n = 0; n < 4; ++n) {
                const bf16x8 b0 = *(const bf16x8*)(ARB + (16 * n + r) * 72 + qd * 8), b1 = *(const bf16x8*)(ARB + (16 * n + r) * 72 + 32 + qd * 8);
                f32x4 cacc = (f32x4){0.f, 0.f, 0.f, 0.f}; cacc = mfma16(aX[0], b0, cacc); cacc = mfma16(aX[1], b1, cacc);
                const float4 rt = *(const float4*)(RTF + (16 * n + r) * 68 + m0 + qd * 4);
                uint2 o; o.x = pack2(rt.x + cacc[0], rt.y + cacc[1]); o.y = pack2(rt.z + cacc[2], rt.w + cacc[3]); *(uint2*)(RQP + (16 * n + r) * 64 + m0 + qd * 4) = o;
            }
        } else {
            bf16x8 aV[2];
#pragma unroll
            for (int ks = 0; ks < 2; ++ks) aV[ks] = *(const bf16x8*)(VT + (m0 + r) * 72 + ks * 32 + qd * 8);
#pragma unroll
            for (int n = 0; n < 4; ++n) {
                const bf16x8 b0 = *(const bf16x8*)(BTT + (16 * n + r) * 72 + qd * 8), b1 = *(const bf16x8*)(BTT + (16 * n + r) * 72 + 32 + qd * 8);
                const bf16x8 k0 = *(const bf16x8*)(KTT + (16 * n + r) * 72 + qd * 8), k1 = *(const bf16x8*)(KTT + (16 * n + r) * 72 + 32 + qd * 8);
                f32x4 cacc = (f32x4){0.f, 0.f, 0.f, 0.f}; cacc = mfma16(aX[0], b0, cacc); cacc = mfma16(aX[1], b1, cacc); cacc = mfma16(aV[0], k0, cacc); cacc = mfma16(aV[1], k1, cacc);
                *(f32x4*)(RRM + (16 * n + r) * 64 + m0 + qd * 4) = cacc;
            }
#pragma unroll
            for (int n = 0; n < 4; ++n) {
                const bf16x8 b0 = *(const bf16x8*)(ARB + (16 * n + r) * 72 + qd * 8), b1 = *(const bf16x8*)(ARB + (16 * n + r) * 72 + 32 + qd * 8);
                const bf16x8 k0 = *(const bf16x8*)(ARK + (16 * n + r) * 72 + qd * 8), k1 = *(const bf16x8*)(ARK + (16 * n + r) * 72 + 32 + qd * 8);
                f32x4 cacc = (f32x4){0.f, 0.f, 0.f, 0.f}; cacc = mfma16(aX[0], b0, cacc); cacc = mfma16(aX[1], b1, cacc); cacc = mfma16(aV[0], k0, cacc); cacc = mfma16(aV[1], k1, cacc);
                *(f32x4*)(ROL + (16 * n + r) * 64 + m0 + qd * 4) = cacc;
            }
        }
    }
}
__device__ __forceinline__ void rwkv_cscan(const Params& p, int seg, int head, unsigned char* shm, bool store_state) {
    const int tidx = ltid(), wave = tidx >> 6, l = tidx & 63, r = l & 15, qd = l >> 4, m0 = (wave & 3) * 16, n0 = (wave >> 2) * 2;
    bf16_t* ZT = (bf16_t*)shm;
    float* SR = (float*)(p.ws + OFF_SR);
    const bf16_t* RPM = (const bf16_t*)(p.ws + OFF_RPM); const float* RRM = (const float*)(p.ws + OFF_RRM); const float* RPC = (const float*)(p.ws + OFF_RPC);
    bf16_t* RZH = (bf16_t*)(p.ws + OFF_RZH);
    f32x4 acc[2];
#pragma unroll
    for (int n = 0; n < 2; ++n)
#pragma unroll
        for (int j = 0; j < 4; ++j) acc[n][j] = seg > 0 ? SR[((size_t)head * 64 + m0 + qd * 4 + j) * 64 + 16 * (n0 + n) + r] : 0.f;
#define RS_PUT(buf_, task_, wr_hist_) { _Pragma("unroll") for (int n = 0; n < 2; ++n) { uint2 o; o.x = pack2(acc[n][0], acc[n][1]); o.y = pack2(acc[n][2], acc[n][3]); \
        *(uint2*)(ZT + ((buf_) * 64 + 16 * (n0 + n) + r) * 72 + m0 + qd * 4) = o; \
        if (wr_hist_) *(uint2*)(RZH + (size_t)(task_) * 4096 + (16 * (n0 + n) + r) * 64 + m0 + qd * 4) = o; } }
    __syncthreads();
    RS_PUT(0, head, true);
    __syncthreads();
    bf16x8 aP[2]; float Rr[2][4]; float pc[4];
    { const int task = head;
#pragma unroll
      for (int ks = 0; ks < 2; ++ks) aP[ks] = *(const bf16x8*)(RPM + (size_t)task * 4096 + (m0 + r) * 64 + ks * 32 + qd * 8);
#pragma unroll
      for (int n = 0; n < 2; ++n)
#pragma unroll
          for (int j = 0; j < 4; ++j) Rr[n][j] = RRM[(size_t)task * 4096 + (m0 + qd * 4 + j) * 64 + 16 * (n0 + n) + r];
#pragma unroll
      for (int j = 0; j < 4; ++j) pc[j] = RPC[(size_t)task * 64 + m0 + qd * 4 + j]; }
    int cur = 0;
#pragma unroll 1
    for (int cn = 0; cn < SEG / 64; ++cn) {
        const int cnn = (cn + 1 < SEG / 64) ? cn + 1 : cn, ntask = cnn * 16 + head;
        bf16x8 nP[2]; float nR[2][4]; float npc[4];
#pragma unroll
        for (int ks = 0; ks < 2; ++ks) nP[ks] = *(const bf16x8*)(RPM + (size_t)ntask * 4096 + (m0 + r) * 64 + ks * 32 + qd * 8);
#pragma unroll
        for (int n = 0; n < 2; ++n)
#pragma unroll
            for (int j = 0; j < 4; ++j) nR[n][j] = RRM[(size_t)ntask * 4096 + (m0 + qd * 4 + j) * 64 + 16 * (n0 + n) + r];
#pragma unroll
        for (int j = 0; j < 4; ++j) npc[j] = RPC[(size_t)ntask * 64 + m0 + qd * 4 + j];
#pragma unroll
        for (int n = 0; n < 2; ++n) {
#pragma unroll
            for (int j = 0; j < 4; ++j) acc[n][j] = acc[n][j] * pc[j] + Rr[n][j];
#pragma unroll
            for (int ks = 0; ks < 2; ++ks) { const bf16x8 b = *(const bf16x8*)(ZT + (cur * 64 + 16 * (n0 + n) + r) * 72 + ks * 32 + qd * 8); acc[n] = mfma16(aP[ks], b, acc[n]); }
        }
        RS_PUT(cur ^ 1, ntask, (cn + 1 < SEG / 64));
        __syncthreads();
        cur ^= 1;
#pragma unroll
        for (int ks = 0; ks < 2; ++ks) aP[ks] = nP[ks];
#pragma unroll
        for (int n = 0; n < 2; ++n)
#pragma unroll
            for (int j = 0; j < 4; ++j) Rr[n][j] = nR[n][j];
#pragma unroll
        for (int j = 0; j < 4; ++j) pc[j] = npc[j];
    }
#undef RS_PUT
    if (store_state)
#pragma unroll
    for (int n = 0; n < 2; ++n)
#pragma unroll
        for (int j = 0; j < 4; ++j) SR[((size_t)head * 64 + m0 + qd * 4 + j) * 64 + 16 * (n0 + n) + r] = acc[n][j];
}
__device__ __forceinline__ void rwkv_cout(const Params& p, int seg) {
    const int tidx = ltid(), wave = tidx >> 6, l = tidx & 63, r = l & 15, qd = l >> 4, i0 = (wave & 3) * 16;
    const bf16_t* RQP = (const bf16_t*)(p.ws + OFF_RQP); const float* ROL = (const float*)(p.ws + OFF_ROL); const bf16_t* RZH = (const bf16_t*)(p.ws + OFF_RZH);
    const float* bonus = (const float*)(p.ws + OFF_BONUS); const float* gate = (const float*)(p.ws + OFF_GATE);
    const float* lnw = p.in[17]; const float* lnb = p.in[18];
    bf16_t* mixed = (bf16_t*)(p.ws + OFF_AB1);
    if (wave >= 4)
    for (int t2 = 0; t2 < 2; ++t2) {
        const int task = lbid() * 2 + t2, h = task & 15, cn = task >> 4;
        bf16x8 aQ[2];
#pragma unroll
        for (int ks = 0; ks < 2; ++ks) aQ[ks] = *(const bf16x8*)(RQP + (size_t)task * 4096 + (i0 + r) * 64 + ks * 32 + qd * 8);
        bf16x8 bz[4][2];
#pragma unroll
        for (int n = 0; n < 4; ++n)
#pragma unroll
            for (int ks = 0; ks < 2; ++ks) bz[n][ks] = *(const bf16x8*)(RZH + (size_t)task * 4096 + (16 * n + r) * 64 + ks * 32 + qd * 8);
        f32x4 acc[4];
#pragma unroll
        for (int n = 0; n < 4; ++n)
#pragma unroll
            for (int j = 0; j < 4; ++j) acc[n][j] = ROL[(size_t)task * 4096 + (i0 + qd * 4 + j) * 64 + 16 * n + r];
#pragma unroll
        for (int n = 0; n < 4; ++n)
#pragma unroll
            for (int ks = 0; ks < 2; ++ks) acc[n] = mfma16(aQ[ks], bz[n][ks], acc[n]);
#pragma unroll
        for (int j = 0; j < 4; ++j) {
            const int tl = cn * 64 + i0 + qd * 4 + j;
            const float mean = allred16((acc[0][j] + acc[1][j]) + (acc[2][j] + acc[3][j])) * (1.f / 64.f);
            float vs = 0.f;
#pragma unroll
            for (int n = 0; n < 4; ++n) { const float d = acc[n][j] - mean; vs += d * d; }
            const float rstd = rsqrtf(allred16(vs) * (1.f / 64.f) + 64e-5f);
#pragma unroll
            for (int n = 0; n < 4; ++n) { const int c = h * 64 + 16 * n + r;
                const float y = (acc[n][j] - mean) * rstd * lnw[c] + lnb[c];
                mixed[(size_t)(seg * SEG + tl) * 2048 + 1024 + c] = f2bf((y + bonus[(size_t)tl * 1024 + c]) * gate[(size_t)tl * 1024 + c]); }
        }
    }
}
__device__ __forceinline__ void gdn_prep_chunk(const Params& p, int seg, int task, unsigned char* shm) {
    const int tidx = ltid();
    const int h = task & 7, cn = task >> 3, tl0 = cn * 64, wave = tidx >> 6, l = tidx & 63;
    float* qf = (float*)(shm + GP_QF); float* kf = (float*)(shm + GP_KF); float* vf = (float*)(shm + GP_VF);
    float* Mm = (float*)(shm + GP_MM); float* Am = (float*)(shm + GP_AM); bf16_t* ktT = (bf16_t*)(shm + GP_KTT); bf16_t* Ab = (bf16_t*)(shm + GP_AB);
    float* sm = (float*)(shm + GP_SM);
    const float* yseg = (const float*)(p.ws + OFF_YSEG);
    const float* carry_prev = (const float*)(p.ws + OFF_CARRY) + (size_t)((seg + 1) & 1) * 3 * NINP;
    const float* cw = p.in[4]; const float* A_log = p.in[5]; const float* dtb = p.in[6];
    float* sz = (float*)(p.ws + OFF_SZ);
    __syncthreads();
    {
        float wq[4][2], wk[4][2], wv[4][2];
#pragma unroll
        for (int j = 0; j < 4; ++j)
#pragma unroll
            for (int e = 0; e < 2; ++e) { const int col = h * 128 + 2 * l + e; wq[j][e] = cw[j * 3072 + col]; wk[j][e] = cw[j * 3072 + 1024 + col]; wv[j][e] = cw[j * 3072 + 2048 + col]; }
        const float nA = -__expf(A_log[h]), db = dtb[h];
        float xq[11][2], xk[11][2], xv[11][2];
#pragma unroll
        for (int rr = 0; rr < 11; ++rr) {
            const int ts = tl0 + wave * 8 - 3 + rr;
            const float* rowp = (ts >= 0) ? (yseg + (size_t)ts * NINP) : (carry_prev + (size_t)(3 + ts) * NINP);
            float2 a2 = make_float2(0.f, 0.f), b2 = a2, c2 = a2;
            if (ts >= 0 || seg > 0) { a2 = *(const float2*)(rowp + h * 128 + 2 * l); b2 = *(const float2*)(rowp + 1024 + h * 128 + 2 * l); c2 = *(const float2*)(rowp + 2048 + h * 128 + 2 * l); }
            xq[rr][0] = a2.x; xq[rr][1] = a2.y; xk[rr][0] = b2.x; xk[rr][1] = b2.y; xv[rr][0] = c2.x; xv[rr][1] = c2.y;
        }
        float2 zz[8]; float adt8 = 0.f, bb8 = 0.f;
#pragma unroll
        for (int q8 = 0; q8 < 8; ++q8) zz[q8] = *(const float2*)(yseg + (size_t)(tl0 + wave * 8 + q8) * NINP + 3072 + h * 128 + 2 * l);
        if (l < 8) { adt8 = yseg[(size_t)(tl0 + wave * 8 + l) * NINP + 4096 + h]; bb8 = yseg[(size_t)(tl0 + wave * 8 + l) * NINP + 4104 + h]; }
#pragma unroll
        for (int q8 = 0; q8 < 8; ++q8) {
            const int tok = wave * 8 + q8, tl = tl0 + tok;
            float qv[2] = {0.f, 0.f}, kv[2] = {0.f, 0.f}, vv[2] = {0.f, 0.f};
#pragma unroll
            for (int j = 0; j < 4; ++j)
#pragma unroll
                for (int e = 0; e < 2; ++e) { qv[e] += wq[j][e] * xq[q8 + j][e]; kv[e] += wk[j][e] * xk[q8 + j][e]; vv[e] += wv[j][e] * xv[q8 + j][e]; }
#pragma unroll
            for (int e = 0; e < 2; ++e) { qv[e] = siluf_(qv[e]); kv[e] = siluf_(kv[e]); vv[e] = siluf_(vv[e]); }
            const float qn = wsum(qv[0] * qv[0] + qv[1] * qv[1]), kn = wsum(kv[0] * kv[0] + kv[1] * kv[1]);
            const float qs = rsqrtf(qn + 1e-6f) * 0.08838834764831845f, ks = rsqrtf(kn + 1e-6f);
            *(float2*)(qf + tok * 132 + 2 * l) = make_float2(qv[0] * qs, qv[1] * qs);
            *(float2*)(kf + tok * 132 + 2 * l) = make_float2(kv[0] * ks, kv[1] * ks);
            *(float2*)(vf + tok * 132 + 2 * l) = make_float2(vv[0], vv[1]);
            *(float2*)(sz + (size_t)tl * 1024 + h * 128 + 2 * l) = make_float2(siluf_(zz[q8].x), siluf_(zz[q8].y));
        }
        if (l < 8) { sm[wave * 8 + l] = nA * softplusf_(adt8 + db); sm[64 + wave * 8 + l] = sigmoidf_(bb8); }
    }
    __syncthreads();
    if (wave == 0) {
        float g = sm[l];
#pragma unroll
        for (int o = 1; o < 64; o <<= 1) { const float t = __shfl_up(g, o); if (l >= o) g += t; }
        const float Gl = __shfl(g, 63);
        sm[l] = g; sm[128 + l] = __expf(g); sm[192 + l] = __expf(Gl - g);
        if (l == 63) ((float*)(p.ws + OFF_EG))[task] = __expf(g);
    }
    __syncthreads();
    {
        const int t2 = ltid(); const int r = t2 & 15, qd = (t2 & 63) >> 4, w2_ = t2 >> 6, prod = w2_ >> 2, m = w2_ & 3;
        const float* Asrc = prod ? qf : kf;
        bf16x8 af[4];
#pragma unroll
        for (int ks = 0; ks < 4; ++ks) { const float4 x0 = *(const float4*)(Asrc + (16 * m + r) * 132 + ks * 32 + qd * 8), x1 = *(const float4*)(Asrc + (16 * m + r) * 132 + ks * 32 + qd * 8 + 4);
            af[ks][0] = (short)f2bf(x0.x); af[ks][1] = (short)f2bf(x0.y); af[ks][2] = (short)f2bf(x0.z); af[ks][3] = (short)f2bf(x0.w);
            af[ks][4] = (short)f2bf(x1.x); af[ks][5] = (short)f2bf(x1.y); af[ks][6] = (short)f2bf(x1.z); af[ks][7] = (short)f2bf(x1.w); }
#pragma unroll
        for (int n = 0; n < 4; ++n) {
            f32x4 cacc = (f32x4){0.f, 0.f, 0.f, 0.f};
#pragma unroll
            for (int ks = 0; ks < 4; ++ks) { const float4 x0 = *(const float4*)(kf + (16 * n + r) * 132 + ks * 32 + qd * 8), x1 = *(const float4*)(kf + (16 * n + r) * 132 + ks * 32 + qd * 8 + 4);
                bf16x8 bfr; bfr[0] = (short)f2bf(x0.x); bfr[1] = (short)f2bf(x0.y); bfr[2] = (short)f2bf(x0.z); bfr[3] = (short)f2bf(x0.w);
                bfr[4] = (short)f2bf(x1.x); bfr[5] = (short)f2bf(x1.y); bfr[6] = (short)f2bf(x1.z); bfr[7] = (short)f2bf(x1.w);
                cacc = mfma16(af[ks], bfr, cacc); }
#pragma unroll
            for (int j = 0; j < 4; ++j) { const int i = 16 * m + qd * 4 + j, jx = 16 * n + r; const float gam = (i >= jx) ? __expf(sm[i] - sm[jx]) : 0.f;
                if (prod == 0) Mm[i * 64 + jx] = (i > jx) ? sm[64 + i] * cacc[j] * gam : 0.f; else Am[i * 64 + jx] = cacc[j] * gam; }
        }
    }
    __syncthreads();
    float* UWg = (float*)(p.ws + OFF_UW) + (size_t)task * 16384;
    if (tidx < 256) {
        float X[64];
        const int c = ltid();
        {
            const float* srcp = (c < 128) ? (vf + c) : (kf + (c - 128));
#pragma unroll
            for (int i = 0; i < 64; ++i) { float sc = sm[64 + i]; if (c >= 128) sc *= sm[128 + i]; X[i] = srcp[i * 132] * sc; }
        }
        solve64<-1>(X, Mm);
#pragma unroll
        for (int i = 0; i < 64; ++i) UWg[i * 256 + c] = X[i];
    }
    else {
        const int t5 = ltid() - 256; const int d = t5 & 127, iq = t5 >> 7;
#pragma unroll 4
        for (int ii = 0; ii < 32; ii += 2) { const int i = iq * 32 + ii;
            *(unsigned*)(ktT + d * 72 + i) = pack2(kf[i * 132 + d] * sm[192 + i], kf[(i + 1) * 132 + d] * sm[192 + i + 1]); }
#pragma unroll 4
        for (int e = 0; e < 8; ++e) { const int idx = (e * 256 + t5) * 2, i = idx >> 6, j = idx & 63;
            *(unsigned*)(Ab + i * 72 + j) = pack2(Am[i * 64 + j], Am[i * 64 + j + 1]); }
#pragma unroll 4
        for (int e = 0; e < 32; ++e) { const int idx = e * 256 + t5, i = idx >> 7, dd = idx & 127; qf[i * 132 + dd] *= sm[128 + i]; }
    }
    __syncthreads();
    {
        const int t4 = ltid(); const int r = t4 & 15, qd = (t4 & 63) >> 4, m0 = (t4 >> 6) * 16;
        bf16x8 aW[2], aU[2];
#pragma unroll
        for (int ks = 0; ks < 2; ++ks)
#pragma unroll
            for (int e = 0; e < 8; ++e) { const float* rp = UWg + (ks * 32 + qd * 8 + e) * 256 + m0 + r; aU[ks][e] = (short)f2bf(rp[0]); aW[ks][e] = (short)f2bf(rp[128]); }
        bf16_t* PMg = (bf16_t*)(p.ws + OFF_PM) + (size_t)task * 16384; float* RNg = (float*)(p.ws + OFF_RN) + (size_t)task * 16384;
        bf16_t* QPg = (bf16_t*)(p.ws + OFF_QP) + (size_t)task * 8192; float* OLg = (float*)(p.ws + OFF_OL) + (size_t)task * 8192;
#pragma unroll 2
        for (int n = 0; n < 8; ++n) {
            const bf16x8 b0 = *(const bf16x8*)(ktT + (16 * n + r) * 72 + qd * 8), b1 = *(const bf16x8*)(ktT + (16 * n + r) * 72 + 32 + qd * 8);
            f32x4 cp = (f32x4){0.f, 0.f, 0.f, 0.f}, cr = (f32x4){0.f, 0.f, 0.f, 0.f};
            cp = mfma16(aW[0], b0, cp); cp = mfma16(aW[1], b1, cp); cr = mfma16(aU[0], b0, cr); cr = mfma16(aU[1], b1, cr);
            const int d = 16 * n + r, c = m0 + qd * 4;
            uint2 o; o.x = pack2(-cp[0], -cp[1]); o.y = pack2(-cp[2], -cp[3]); *(uint2*)(PMg + d * 128 + c) = o;
            *(f32x4*)(RNg + d * 128 + c) = cr;
        }
#pragma unroll 2
        for (int n = 0; n < 4; ++n) {
            const bf16x8 b0 = *(const bf16x8*)(Ab + (16 * n + r) * 72 + qd * 8), b1 = *(const bf16x8*)(Ab + (16 * n + r) * 72 + 32 + qd * 8);
            f32x4 cq = (f32x4){0.f, 0.f, 0.f, 0.f}, co = (f32x4){0.f, 0.f, 0.f, 0.f};
            cq = mfma16(aW[0], b0, cq); cq = mfma16(aW[1], b1, cq); co = mfma16(aU[0], b0, co); co = mfma16(aU[1], b1, co);
            const int i = 16 * n + r, dm = m0 + qd * 4;
            const float4 qv = *(const float4*)(qf + i * 132 + dm);
            uint2 o; o.x = pack2(qv.x - cq[0], qv.y - cq[1]); o.y = pack2(qv.z - cq[2], qv.w - cq[3]); *(uint2*)(QPg + i * 128 + dm) = o;
            *(f32x4*)(OLg + i * 128 + dm) = co;
        }
    }
}

__device__ __forceinline__ void rwkv_scan(const Params& p, int seg, int hb, float* lds, bool store_state) {
    const int tidx = ltid();
    const float* rrec = (const float*)(p.ws + OFF_RREC); float* orw = (float*)(p.ws + OFF_ORW); float* SR = (float*)(p.ws + OFF_SR);
    const int tid = tidx, wave = tid >> 6, lane = tid & 63, head = hb >> 2, rq = hb & 3;
    const int row = rq * 16 + (wave & 3) * 4 + (lane >> 4), j = lane & 15;
    constexpr int TS = 32, TF = TS * RREC;
    f32x2 S01 = (f32x2){0.f, 0.f}, S23 = (f32x2){0.f, 0.f};
    if (wave < 4 && seg > 0) { const float4 S = *(const float4*)(SR + ((size_t)head * 64 + row) * 64 + 4 * j); S01 = (f32x2){S.x, S.y}; S23 = (f32x2){S.z, S.w}; }
    float4 rg0, rg1, rg2, rg3, rg4, rg5;
#define RW_GL(R, i, tile_) { const int e = tid + (i) * 512, st = e / 96, off = e % 96; R = *(const float4*)(rrec + ((size_t)((tile_) * TS + st) * 16 + head) * RREC + off * 4); }
#define RW_GLOAD(tile_) { RW_GL(rg0, 0, tile_) RW_GL(rg1, 1, tile_) RW_GL(rg2, 2, tile_) RW_GL(rg3, 3, tile_) RW_GL(rg4, 4, tile_) RW_GL(rg5, 5, tile_) }
#define RW_LS(R, i, buf_) { *(float4*)(lds + (buf_) * TF + (tid + (i) * 512) * 4) = R; }
#define RW_LSTORE(buf_) { RW_LS(rg0, 0, buf_) RW_LS(rg1, 1, buf_) RW_LS(rg2, 2, buf_) RW_LS(rg3, 3, buf_) RW_LS(rg4, 4, buf_) RW_LS(rg5, 5, buf_) }
    __syncthreads();
    RW_GLOAD(0); RW_LSTORE(0); __syncthreads();
    int cur = 0;
    for (int tile = 0; tile < SEG / TS; ++tile) {
        const int ntile = (tile + 1 < SEG / TS) ? tile + 1 : tile;
        RW_GLOAD(ntile);
        if (wave < 4) {
            const float* base = lds + cur * TF + 4 * j;
            const float* vbase = lds + cur * TF + 320 + row;
            f32x4 w4 = *(const f32x4*)(base), a4 = *(const f32x4*)(base + 64), b4 = *(const f32x4*)(base + 128), k4 = *(const f32x4*)(base + 192), r4 = *(const f32x4*)(base + 256);
            float vv = vbase[0];
            float obuf = 0.f;
#pragma unroll 16
            for (int st = 0; st < TS; ++st) {
                const float* nb = base + (st + 1) * RREC;
                const f32x4 nw4 = *(const f32x4*)(nb), na4 = *(const f32x4*)(nb + 64), nb4 = *(const f32x4*)(nb + 128), nk4 = *(const f32x4*)(nb + 192), nr4 = *(const f32x4*)(nb + 256);
                const float nvv = vbase[(st + 1) * RREC];
                const f32x2 a01 = __builtin_shufflevector(a4, a4, 0, 1), a23 = __builtin_shufflevector(a4, a4, 2, 3);
                f32x2 t = S01 * a01; t = S23 * a23 + t;
                const float sa = allred16(t[0] + t[1]);
                const f32x2 sa2 = (f32x2){sa, sa}, v2 = (f32x2){vv, vv};
                const f32x2 b01 = __builtin_shufflevector(b4, b4, 0, 1), b23 = __builtin_shufflevector(b4, b4, 2, 3);
                const f32x2 k01 = __builtin_shufflevector(k4, k4, 0, 1), k23 = __builtin_shufflevector(k4, k4, 2, 3);
                const f32x2 w01 = __builtin_shufflevector(w4, w4, 0, 1), w23 = __builtin_shufflevector(w4, w4, 2, 3);
                f32x2 u01 = v2 * k01; u01 = sa2 * b01 + u01; S01 = S01 * w01 + u01;
                f32x2 u23 = v2 * k23; u23 = sa2 * b23 + u23; S23 = S23 * w23 + u23;
                const f32x2 r01 = __builtin_shufflevector(r4, r4, 0, 1), r23 = __builtin_shufflevector(r4, r4, 2, 3);
                f32x2 q = S01 * r01; q = S23 * r23 + q;
                const float o = allred16(q[0] + q[1]);
                obuf = ((st & 15) == j) ? o : obuf;
                if ((st & 15) == 15) orw[(size_t)(tile * TS + (st & ~15) + j) * 1024 + head * 64 + row] = obuf;
                w4 = nw4; a4 = na4; b4 = nb4; k4 = nk4; r4 = nr4; vv = nvv;
            }
        }
        RW_LSTORE(cur ^ 1);
        __syncthreads();
        cur ^= 1;
    }
#undef RW_GL
#undef RW_GLOAD
#undef RW_LS
#undef RW_LSTORE
    if (wave < 4 && store_state) *(float4*)(SR + ((size_t)head * 64 + row) * 64 + 4 * j) = make_float4(S01[0], S01[1], S23[0], S23[1]);
}
__device__ __forceinline__ void gdn_scan(const Params& p, int seg, int gb, unsigned char* shm, bool store_state) {
    const int tidx = ltid(), wave = tidx >> 6, l = tidx & 63, r = l & 15, qd = l >> 4;
    const int head = gb >> 2, c0 = (gb & 3) * 32, m0 = wave * 16;
    bf16_t* ST = (bf16_t*)shm;
    float* SG = (float*)(p.ws + OFF_SG);
    const bf16_t* PM = (const bf16_t*)(p.ws + OFF_PM); const float* RN = (const float*)(p.ws + OFF_RN); const float* EG = (const float*)(p.ws + OFF_EG);
    bf16_t* SH = (bf16_t*)(p.ws + OFF_SH);
    f32x4 acc[2];
#pragma unroll
    for (int n = 0; n < 2; ++n)
#pragma unroll
        for (int j = 0; j < 4; ++j) acc[n][j] = seg > 0 ? SG[((size_t)head * 128 + m0 + qd * 4 + j) * 128 + c0 + 16 * n + r] : 0.f;
#define GS_PUT(buf_, task_, wr_hist_) { _Pragma("unroll") for (int n = 0; n < 2; ++n) { uint2 o; o.x = pack2(acc[n][0], acc[n][1]); o.y = pack2(acc[n][2], acc[n][3]); \
        *(uint2*)(ST + ((buf_) * 32 + 16 * n + r) * 136 + m0 + qd * 4) = o; \
        if (wr_hist_) *(uint2*)(SH + (size_t)(task_) * 16384 + (c0 + 16 * n + r) * 128 + m0 + qd * 4) = o; } }
    __syncthreads();
    GS_PUT(0, head, true);
    __syncthreads();
    bf16x8 aP[4]; float Rr[2][4]; float eg;
    { const int task = head;
#pragma unroll
      for (int ks = 0; ks < 4; ++ks) aP[ks] = *(const bf16x8*)(PM + (size_t)task * 16384 + (m0 + r) * 128 + ks * 32 + qd * 8);
#pragma unroll
      for (int n = 0; n < 2; ++n)
#pragma unroll
          for (int j = 0; j < 4; ++j) Rr[n][j] = RN[(size_t)task * 16384 + (m0 + qd * 4 + j) * 128 + c0 + 16 * n + r];
      eg = EG[task]; }
    int cur = 0;
#pragma unroll 1
    for (int cn = 0; cn < SEG / 64; ++cn) {
        const int cnn = (cn + 1 < SEG / 64) ? cn + 1 : cn, ntask = cnn * 8 + head;
        bf16x8 nP[4]; float nR[2][4];
#pragma unroll
        for (int ks = 0; ks < 4; ++ks) nP[ks] = *(const bf16x8*)(PM + (size_t)ntask * 16384 + (m0 + r) * 128 + ks * 32 + qd * 8);
#pragma unroll
        for (int n = 0; n < 2; ++n)
#pragma unroll
            for (int j = 0; j < 4; ++j) nR[n][j] = RN[(size_t)ntask * 16384 + (m0 + qd * 4 + j) * 128 + c0 + 16 * n + r];
        const float neg = EG[ntask];
#pragma unroll
        for (int n = 0; n < 2; ++n) {
#pragma unroll
            for (int j = 0; j < 4; ++j) acc[n][j] = acc[n][j] * eg + Rr[n][j];
#pragma unroll
            for (int ks = 0; ks < 4; ++ks) { const bf16x8 b = *(const bf16x8*)(ST + (cur * 32 + 16 * n + r) * 136 + ks * 32 + qd * 8); acc[n] = mfma16(aP[ks], b, acc[n]); }
        }
        GS_PUT(cur ^ 1, ntask, (cn + 1 < SEG / 64));
        __syncthreads();
        cur ^= 1;
#pragma unroll
        for (int ks = 0; ks < 4; ++ks) aP[ks] = nP[ks];
#pragma unroll
        for (int n = 0; n < 2; ++n)
#pragma unroll
            for (int j = 0; j < 4; ++j) Rr[n][j] = nR[n][j];
        eg = neg;
    }
#undef GS_PUT
    if (store_state)
#pragma unroll
    for (int n = 0; n < 2; ++n)
#pragma unroll
        for (int j = 0; j < 4; ++j) SG[((size_t)head * 128 + m0 + qd * 4 + j) * 128 + c0 + 16 * n + r] = acc[n][j];
}
__device__ __forceinline__ void gdn_out(const Params& p, int seg) {
    const int tidx = ltid(), wave = tidx >> 6, l = tidx & 63, r = l & 15, qd = l >> 4, i0 = (wave & 3) * 16;
    const bf16_t* QP = (const bf16_t*)(p.ws + OFF_QP); const float* OL = (const float*)(p.ws + OFF_OL); const bf16_t* SH = (const bf16_t*)(p.ws + OFF_SH);
    const float* sz = (const float*)(p.ws + OFF_SZ); const float* gnw = p.in[7];
    bf16_t* mixed = (bf16_t*)(p.ws + OFF_AB1);
    if (wave < 4) {
        const int task = lbid(), h = task & 7, cn = task >> 3;
        bf16x8 aQ[4];
#pragma unroll
        for (int ks = 0; ks < 4; ++ks) aQ[ks] = *(const bf16x8*)(QP + (size_t)task * 8192 + (i0 + r) * 128 + ks * 32 + qd * 8);
        f32x4 acc[8];
#pragma unroll
        for (int n = 0; n < 8; ++n)
#pragma unroll
            for (int j = 0; j < 4; ++j) acc[n][j] = OL[(size_t)task * 8192 + (i0 + qd * 4 + j) * 128 + 16 * n + r];
#pragma unroll
        for (int n = 0; n < 8; ++n)
#pragma unroll
            for (int ks = 0; ks < 4; ++ks) { const bf16x8 b = *(const bf16x8*)(SH + (size_t)task * 16384 + (16 * n + r) * 128 + ks * 32 + qd * 8); acc[n] = mfma16(aQ[ks], b, acc[n]); }
#pragma unroll
        for (int j = 0; j < 4; ++j) {
            float ss = 0.f;
#pragma unroll
            for (int n = 0; n < 8; ++n) ss += acc[n][j] * acc[n][j];
            ss = allred16(ss);
            const float rs = rsqrtf(ss * (1.f / 128.f) + 1e-6f);
            const int tl = cn * 64 + i0 + qd * 4 + j;
#pragma unroll
            for (int n = 0; n < 8; ++n) { const int c = 16 * n + r;
                mixed[(size_t)(seg * SEG + tl) * 2048 + h * 128 + c] = f2bf(acc[n][j] * rs * gnw[c] * sz[(size_t)tl * 1024 + h * 128 + c]); }
        }
    }
}

__device__ __forceinline__ void mixer_post(const Params& p, int seg) {
    const int tidx = ltid();
    const float* orw = (const float*)(p.ws + OFF_ORW);
    const float* sz = (const float*)(p.ws + OFF_SZ); const float* bonus = (const float*)(p.ws + OFF_BONUS); const float* gate = (const float*)(p.ws + OFF_GATE);
    const float* lnw = p.in[17]; const float* lnb = p.in[18];
    bf16_t* mixed = (bf16_t*)(p.ws + OFF_AB1);
    const int gw = blockIdx.x * 8 + (tidx >> 6), nw = gridDim.x * 8, l = tidx & 63;
    for (int tl = gw; tl < SEG; tl += nw) {
        bf16_t* mrow = mixed + (size_t)(seg * SEG + tl) * 2048;
#pragma unroll 2
        for (int h = 0; h < 16; ++h) {
            const int c = h * 64 + l;
            const float o = orw[(size_t)tl * 1024 + c];
            const float mean = wsum(o) * (1.f / 64.f); const float d = o - mean; const float var = wsum(d * d) * (1.f / 64.f);
            const float y = d * rsqrtf(var + 64e-5f) * lnw[c] + lnb[c];
            mrow[1024 + c] = f2bf((y + bonus[(size_t)tl * 1024 + c]) * gate[(size_t)tl * 1024 + c]);
        }
    }
}

#ifndef GM
#define GM 0xFFFFFFFFu
#endif
#ifndef REP_P0
#define REP_P0 1
#endif
#ifndef REP_PREP
#define REP_PREP 1
#endif
#ifndef REP_INPROJ
#define REP_INPROJ 1
#endif
#ifndef REP_UP
#define REP_UP 1
#endif
#ifndef REP_WOUT
#define REP_WOUT 1
#endif
#ifndef REP_RT
#define REP_RT 1
#endif
#ifndef REP_RC
#define REP_RC 1
#endif
#ifndef REP_GP
#define REP_GP 1
#endif
#ifndef REP_SCAN
#define REP_SCAN 1
#endif
#ifndef REP_POST
#define REP_POST 1
#endif
constexpr unsigned PH_ALL = 0x1FFFu;
template <unsigned PH> __global__ void __launch_bounds__(512, 2) mega(Params p, int seg_lo, int seg_hi) {
    extern __shared__ __attribute__((aligned(16))) unsigned char shm[];
    LAS unsigned char* lds_ = (LAS unsigned char*)shm;
#define SYNC0() do { if constexpr (PH == PH_ALL) cg::this_grid().sync(); } while (0)
#define SYNC() do { if constexpr (PH == PH_ALL) xcd_barrier(xb); } while (0)
    XcdBarrier xb; xb.bar = nullptr; xb.x = 0; xb.st = (volatile LAS unsigned*)(lds_ + (LDS_BYTES - 16));
    if constexpr (PH == PH_ALL) {
        if (threadIdx.x == 0) { xb.st[0] = 0u; xb.st[1] = 0u; }
        __syncthreads();
        xb = xcd_barrier_post((unsigned*)(p.ws + OFF_BAR), (volatile LAS unsigned*)(lds_ + (LDS_BYTES - 16)));
    }
    LAS unsigned char* lds = (LAS unsigned char*)shm;
    float* ldsf = (float*)shm;
#define WSB (p.ws)
#define WIN ((bf16_t*)(WSB + OFF_WIN))
#define WOUT ((bf16_t*)(WSB + OFF_WOUT))
#define WQ ((bf16_t*)(WSB + OFF_WQ))
#define WK ((bf16_t*)(WSB + OFF_WK))
#define WV ((bf16_t*)(WSB + OFF_WV))
#define WO ((bf16_t*)(WSB + OFF_WO))
#define WUP ((bf16_t*)(WSB + OFF_WUP))
#define WDN ((bf16_t*)(WSB + OFF_WDN))
#define MN ((bf16_t*)(WSB + OFF_MN))
#define KX ((bf16_t*)(WSB + OFF_KX))
#define VT ((bf16_t*)(WSB + OFF_VT))
#define RSTDX ((float*)(WSB + OFF_RSTDX))
#define SSQ1 ((float*)(WSB + OFF_SSQ1))
#define SSQ2 ((float*)(WSB + OFF_SSQ2))
#define PROW ((float*)(WSB + OFF_PROW))
#define AB0 ((bf16_t*)(WSB + OFF_AB0))
#define AB1 ((bf16_t*)(WSB + OFF_AB1))
#define UB ((bf16_t*)(WSB + OFF_U))
#define YSEG ((float*)(WSB + OFF_YSEG))

    if constexpr (PH & 1u) for (int rep_ = 0; rep_ < REP_P0; ++rep_) {
    convT(p.in[3], WIN, p.in[2], D, NIN, NINP, ldsf);
    convT(p.in[23], WK, nullptr, D, D, D, ldsf);
    convT(p.in[24], WV, nullptr, D, D, D, ldsf);
    rows_to_bf16(p.in[0], AB0, RSTDX, nullptr, T);
    rows_to_bf16(p.in[1], MN, nullptr, p.in[21], 256);
    }
    SYNC0();

    if constexpr (PH & 0xEu)
    for (int seg = seg_lo; seg < seg_hi; ++seg) {
        const int bid = lbid();
        if (seg >= 0) {
            if constexpr (PH & 2u) { if (seg > 0) for (int rep_ = 0; rep_ < REP_POST; ++rep_) { gdn_out(p, seg - 1); rwkv_cout(p, seg - 1); } }
            if (seg == NSEG) { SYNC(); break; }
            if constexpr (PH & 4u) for (int rep_ = 0; rep_ < REP_PREP; ++rep_) {
                for (int r2_ = 0; r2_ < REP_RT; ++r2_) rwkv_prep_tile(p, seg, bid >> 3, bid & 7, ldsf);
                __syncthreads();
                for (int r2_ = 0; r2_ < REP_RC; ++r2_) { rwkv_chunk_prep(p, seg, bid >> 3, (bid & 7) * 2, shm); rwkv_chunk_prep(p, seg, bid >> 3, (bid & 7) * 2 + 1, shm); }
                for (int r2_ = 0; r2_ < REP_GP; ++r2_) gdn_prep_chunk(p, seg, bid, shm);
                if (bid == 255) {
                    float* carry = (float*)(WSB + OFF_CARRY) + (size_t)(seg & 1) * 3 * NINP;
                    for (int i = ltid(); i < 3 * NINP; i += 512) carry[i] = YSEG[(size_t)(SEG - 3) * NINP + i];
                }
            }
            SYNC();
        }
        if constexpr (PH & 8u) for (int rep_ = 0; rep_ < REP_SCAN; ++rep_) {
            if (seg >= 0) {
                if (bid < 32) gdn_scan(p, seg, bid, shm, rep_ == REP_SCAN - 1);
                if (bid >= 32 && bid < 48) rwkv_cscan(p, seg, bid - 32, shm, rep_ == REP_SCAN - 1);
            }
            if ((seg < 0 || bid >= 48) && rep_ == 0) {
                const int ob = seg < 0 ? (int)bid : (int)bid - 48, on = seg < 0 ? (int)gridDim.x : (int)gridDim.x - 48;
                if (seg + 1 < NSEG) { EpiY e; e.Y = YSEG; e.ldc = NINP; e.rstd = RSTDX + (seg + 1) * SEG;
                    for (int r3_ = 0; r3_ < REP_INPROJ; ++r3_) run_gemm(lds, AB0 + (size_t)(seg + 1) * SEG * D, WIN, D, D, D, SEG / 256, NINP / 256, 1, 0, 0, e, 0, on, ob); }
                __syncthreads();
                if (seg >= 0 && seg < 7) {
                    const int wi = seg == 0 ? 19 : seg == 1 ? 22 : seg == 2 ? 25 : seg <= 4 ? 27 : 28;
                    const size_t wo_ = seg == 0 ? OFF_WOUT : seg == 1 ? OFF_WQ : seg == 2 ? OFF_WO : seg <= 4 ? OFF_WUP : OFF_WDN;
                    const float* cg = seg == 1 ? p.in[20] : (seg == 3 || seg == 4) ? p.in[26] : nullptr;
                    const int cK = seg >= 5 ? DFF : D, cN = (seg == 3 || seg == 4) ? DFF : D;
                    const int ct0 = (seg == 4 || seg == 6) ? 2048 : 0, ct1 = (seg == 3 || seg == 5) ? 2048 : (1 << 30);
                    if (ob >= 32) convT(p.in[wi], (bf16_t*)(WSB + wo_), cg, cK, cN, cN, ldsf, ob - 32, on - 32, ct0, ct1);
                }
            }
        }
        if (seg < 0) {
            if constexpr (PH & 8u) {
                { EpiBf e; e.O = KX; e.ldc = D; e.ssq = nullptr; e.cache = nullptr; run_gemm(lds, MN, WK, D, D, D, 1, 8, 1, 0, 0, e, 16); }
                { EpiBf e; e.O = VT; e.ldc = 256; e.ssq = nullptr; e.cache = nullptr; run_gemm(lds, WV, MN, D, D, D, 8, 1, 1, 0, 0, e, 8); }
            }
        }
        SYNC();
    }
    if constexpr (PH & 32u) { EpiRes<false, true> e; e.Rb = AB0; e.H = nullptr; e.HB = AB0; e.ssq = SSQ1; for (int rw_ = 0; rw_ < REP_WOUT; ++rw_) run_gemm(lds, AB1, WOUT, D, D, D, T / 256, 8, 1, 0, 0, e, 0); }
    SYNC();
    if constexpr (PH & 64u) { EpiBf e; e.O = AB1; e.ldc = D; e.ssq = SSQ1; e.cache = (LAS float*)(lds + 131072); e.cache[ltid() * 12] = __int_as_float(-1); if (GM & (1u << 4)) run_gemm(lds, AB0, WQ, D, D, D, T / 256, 8, 1, 0, 0, e, 0); }
    SYNC();
    if constexpr (PH & 128u) { EpiScore e; e.P = (bf16_t*)p.out; e.prow = PROW; e.scale = 0.044194173824159216f; if (GM & (1u << 5)) run_gemm(lds, AB1, KX, D, D, 512, T / 256, 1, 4, 512, 512, e, 0); }
    SYNC();
    if constexpr (PH & 256u) { EpiPV e; e.O = AB1; e.prow = PROW; if (GM & (1u << 6)) run_gemm(lds, (const bf16_t*)p.out, VT, 1024, 256, 256, T / 256, 2, 4, 256, (size_t)512 * 256, e, 0); }
    SYNC();
    if constexpr (PH & 512u) { EpiRes<false, true> e; e.Rb = AB0; e.H = nullptr; e.HB = AB0; e.ssq = SSQ2; if (GM & (1u << 7)) run_gemm(lds, AB1, WO, D, D, D, T / 256, 8, 1, 0, 0, e, 0); }
    SYNC();
    if constexpr (PH & 1024u) { EpiUp e; e.O = UB; e.ldc = DFF; e.ssq = SSQ2; e.cache = (LAS float*)(lds + 131072); e.cache[ltid() * 12] = __int_as_float(-1); for (int rep_ = 0; rep_ < REP_UP; ++rep_) run_gemm(lds, AB0, WUP, D, D, D, T / 256, DFF / 256, 1, 0, 0, e, 0); }
    SYNC();
    if constexpr (PH & 2048u) { EpiRes<false, true> e; e.Rb = AB0; e.H = nullptr; e.HB = AB0; e.ssq = SSQ1; if (GM & (1u << 9)) run_gemm(lds, UB, WDN, DFF, DFF, DFF, T / 256, 8, 1, 0, 0, e, 0); }
    SYNC();
    if constexpr (PH & 4096u) {
        const float* gain = p.in[29];
        const bf16_t* h3 = AB0; const float* ssq = SSQ1;
        const int tidx = ltid(); const int gw = blockIdx.x * 8 + (tidx >> 6), nw = gridDim.x * 8, lane = tidx & 63;
        float4 g0[4], g1[4];
#pragma unroll
        for (int i = 0; i < 4; ++i) { g0[i] = ((const float4*)gain)[(i * 64 + lane) * 2]; g1[i] = ((const float4*)gain)[(i * 64 + lane) * 2 + 1]; }
        for (int ra = gw; ra < T; ra += 2 * nw) {
            const int rb = ra + nw;
            const uint4* ha = (const uint4*)(h3 + (size_t)ra * 2048); const uint4* hb = (const uint4*)(h3 + (size_t)rb * 2048);
            uint4 va[4], vb[4];
#pragma unroll
            for (int i = 0; i < 4; ++i) { va[i] = ha[i * 64 + lane]; vb[i] = hb[i * 64 + lane]; }
            float sa = (lane < 32) ? ssq[(size_t)ra * 32 + lane] : 0.f, sb = (lane < 32) ? ssq[(size_t)rb * 32 + lane] : 0.f;
            sa = wsum(sa); sb = wsum(sb);
            const float rsa = rsqrtf(sa * (1.f / 2048.f) + 1e-6f), rsb = rsqrtf(sb * (1.f / 2048.f) + 1e-6f);
#pragma unroll
            for (int q = 0; q < 2; ++q) {
                const float rs = q ? rsb : rsa; float4* pr = (float4*)(p.out + (size_t)(q ? rb : ra) * 2048);
#pragma unroll
                for (int i = 0; i < 4; ++i) { const uint4 hv = q ? vb[i] : va[i];
                    float4 o0, o1;
                    o0.x = __uint_as_float(hv.x << 16) * rs * g0[i].x; o0.y = __uint_as_float(hv.x & 0xFFFF0000u) * rs * g0[i].y; o0.z = __uint_as_float(hv.y << 16) * rs * g0[i].z; o0.w = __uint_as_float(hv.y & 0xFFFF0000u) * rs * g0[i].w;
                    o1.x = __uint_as_float(hv.z << 16) * rs * g1[i].x; o1.y = __uint_as_float(hv.z & 0xFFFF0000u) * rs * g1[i].y; o1.z = __uint_as_float(hv.w << 16) * rs * g1[i].z; o1.w = __uint_as_float(hv.w & 0xFFFF0000u) * rs * g1[i].w;
                    pr[(i * 64 + lane) * 2] = o0; pr[(i * 64 + lane) * 2 + 1] = o1; }
            }
        }
    }
}

extern "C" void kernel_launch(void* const* d_in, const int* in_sizes, int n_in, void* d_out, int out_size, void* d_ws, size_t ws_size, hipStream_t stream) {
    Params p{};
    for (int i = 0; i < 30; ++i) p.in[i] = (const float*)d_in[i];
    p.out = (float*)d_out; p.ws = (unsigned char*)d_ws;
#ifdef ONE_LAUNCH
    static int grid_blocks = 0;
    if (!grid_blocks) {
        (void)hipFuncSetAttribute((const void*)mega<PH_ALL>, hipFuncAttributeMaxDynamicSharedMemorySize, LDS_BYTES);
        int dev = 0, cus = 0, per_cu = 0;
        (void)hipGetDevice(&dev);
        (void)hipDeviceGetAttribute(&cus, hipDeviceAttributeMultiprocessorCount, dev);
        (void)hipOccupancyMaxActiveBlocksPerMultiprocessor(&per_cu, mega<PH_ALL>, 512, LDS_BYTES);
        grid_blocks = (cus * per_cu >= 256) ? 256 : cus * per_cu;
    }
    (void)hipMemsetAsync((unsigned char*)d_ws + OFF_BAR, 0, XCD_BAR_WORDS * 4, stream);
    int lo = -1, hi = NSEG + 1;
    void* args[] = {&p, &lo, &hi};
    hipError_t e = hipLaunchCooperativeKernel((void*)mega<PH_ALL>, dim3(grid_blocks), dim3(512), args, LDS_BYTES, stream);
    if (e != hipSuccess) fprintf(stderr, "cooperative launch failed: %s (grid %d)\n", hipGetErrorString(e), grid_blocks);
#else
    static int init = 0;
#define SETA(PHV) (void)hipFuncSetAttribute((const void*)mega<PHV>, hipFuncAttributeMaxDynamicSharedMemorySize, LDS_BYTES)
    if (!init) { init = 1; SETA(1u); SETA(2u); SETA(4u); SETA(8u); SETA(32u); SETA(64u); SETA(128u); SETA(256u); SETA(512u); SETA(1024u); SETA(2048u); SETA(4096u); }
#define L(PHV, lo, hi) mega<PHV><<<256, 512, LDS_BYTES, stream>>>(p, lo, hi)
    L(1u, 0, 0);
    L(8u, -1, 0);
    for (int s = 0; s < NSEG; ++s) { L(2u, s, s + 1); L(4u, s, s + 1); L(8u, s, s + 1); }
    L(2u, NSEG, NSEG + 1); L(32u, 0, 0); L(64u, 0, 0); L(128u, 0, 0); L(256u, 0, 0); L(512u, 0, 0); L(1024u, 0, 0); L(2048u, 0, 0); L(4096u, 0, 0);
#endif
}
```
